# Optimizing an MI355X kernel written in HIP

```python
import jax, jax.numpy as jnp
from jax import lax
import numpy as np

D_MODEL = 1024
BATCH = 8
SEQ = 4096
DEPTH = 4

N_MIXERS = 2
N_GLA = (DEPTH + 1) // 2
N_POOL = DEPTH // 2
EPS = 1e-6
D_FF = 2816
GLA_HEADS = 4
GLA_KD = D_MODEL // 2
GLA_VD = D_MODEL
GLA_DK = GLA_KD // GLA_HEADS
GLA_DV = GLA_VD // GLA_HEADS
GATE_RANK = 16
GATE_TAU = 16.0
CHUNK = 64
POOL_WINDOWS = (2, 4, 8, 16)
POOL_GROUPS = len(POOL_WINDOWS)
POOL_GC = D_MODEL // POOL_GROUPS
MEM_LEN = 256
X_HEADS = 4
X_DH = D_MODEL // X_HEADS

kernel_name = "hybrid_gla_pool_macaron_memxattn"


def rmsnorm(x, g):
    xf = x.astype(jnp.float32)
    y = xf * lax.rsqrt(jnp.mean(xf * xf, axis=-1, keepdims=True) + EPS)
    return (y * g.astype(jnp.float32)).astype(x.dtype)


def swiglu_ffn(h, w_gu, w_down):
    g, u = jnp.split(h @ w_gu, 2, axis=-1)
    return (jax.nn.silu(g) * u) @ w_down


def gla_mixer(h, w_in, w_g1, w_g2, b_g, g_onorm, w_out):
    B, S, _ = h.shape
    N = S // CHUNK
    f32 = jnp.float32
    proj = h @ w_in
    q, k, v, r = jnp.split(proj, [GLA_KD, 2 * GLA_KD, 2 * GLA_KD + GLA_VD], axis=-1)
    glog = jax.nn.log_sigmoid(((h @ w_g1) @ w_g2 + b_g).astype(f32)) / GATE_TAU

    def heads(t, dh):
        return t.reshape(B, N, CHUNK, GLA_HEADS, dh).transpose(0, 3, 1, 2, 4).astype(f32)

    q = heads(q, GLA_DK) * (GLA_DK ** -0.5)
    k = heads(k, GLA_DK)
    v = heads(v, GLA_DV)
    b = jnp.cumsum(heads(glog, GLA_DK), axis=3)
    b_last = b[:, :, :, -1:, :]
    b_ref = b[:, :, :, CHUNK // 2 - 1:CHUNK // 2, :]

    A = jnp.einsum('bhnik,bhnjk->bhnij', q * jnp.exp(b - b_ref), k * jnp.exp(b_ref - b))
    causal = jnp.tril(jnp.ones((CHUNK, CHUNK), dtype=bool))
    A = jnp.where(causal, A, 0.0)
    o_intra = jnp.einsum('bhnij,bhnjv->bhniv', A, v)

    q_in = q * jnp.exp(b)
    k_st = k * jnp.exp(b_last - b)
    decay = jnp.exp(b_last[:, :, :, 0, :])

    def step(state, xs):
        qn, kn, vn, dn = xs
        o = jnp.einsum('bhik,bhkv->bhiv', qn, state)
        state = dn[..., None] * state + jnp.einsum('bhjk,bhjv->bhkv', kn, vn)
        return state, o

    xs = tuple(jnp.moveaxis(t, 2, 0) for t in (q_in, k_st, v, decay))
    s0 = jnp.zeros((B, GLA_HEADS, GLA_DK, GLA_DV), f32)
    _, o_inter = lax.scan(step, s0, xs)
    o = o_intra + jnp.moveaxis(o_inter, 0, 2)
    o = o.transpose(0, 2, 3, 1, 4).reshape(B, S, GLA_HEADS, GLA_DV)
    o = rmsnorm(o, g_onorm).reshape(B, S, GLA_VD)
    o = (o * jax.nn.silu(r.astype(f32))).astype(h.dtype)
    return o @ w_out


def causal_window_mean(u, w):
    S = u.shape[1]
    cs = jnp.cumsum(u.astype(jnp.float32), axis=1)
    cs = jnp.pad(cs, ((0, 0), (1, 0), (0, 0)))
    upper = cs[:, 1:]
    lower = jnp.pad(cs, ((0, 0), (w - 1, 0), (0, 0)))[:, :S]
    count = jnp.minimum(jnp.arange(1, S + 1), w).astype(jnp.float32)
    return (upper - lower) / count[None, :, None]


def pool_mixer(h, w_grp, b_grp, scale):
    B, S, _ = h.shape
    groups = []
    for gi, w in enumerate(POOL_WINDOWS):
        u = h[..., gi * POOL_GC:(gi + 1) * POOL_GC]
        groups.append(causal_window_mean(u, w) - u.astype(jnp.float32))
    p = jnp.stack(groups, axis=2).astype(h.dtype)
    y = jnp.einsum('bsgc,gcd->bsgd', p, w_grp) + b_grp
    return y.reshape(B, S, D_MODEL) * scale


def mem_cross_attn(h, mem_n, w_q, w_kv, w_o):
    B, S, _ = h.shape
    q = (h @ w_q).reshape(B, S, X_HEADS, X_DH)
    k, v = jnp.split(mem_n @ w_kv, 2, axis=-1)
    k = k.reshape(B, MEM_LEN, X_HEADS, X_DH)
    v = v.reshape(B, MEM_LEN, X_HEADS, X_DH)
    s = jnp.einsum('bshd,bmhd->bhsm', q, k).astype(jnp.float32) * (X_DH ** -0.5)
    p = jax.nn.softmax(s, axis=-1).astype(h.dtype)
    o = jnp.einsum('bhsm,bmhd->bshd', p, v).reshape(B, S, D_MODEL)
    return o @ w_o


def setup_inputs(seed: int = 0) -> dict:
    key = jax.random.key(seed)
    ks = iter(jax.random.split(key, 40))

    def nrm(shape, fan_in):
        return jax.random.normal(next(ks), shape, jnp.float32) * (fan_in ** -0.5)

    def gain(shape):
        return 1.0 + 0.02 * jax.random.normal(next(ks), shape, jnp.float32)

    def small(shape):
        return 0.01 * jax.random.normal(next(ks), shape, jnp.float32)

    D = D_MODEL
    return {
        "x": jax.random.normal(next(ks), (BATCH, SEQ, D), jnp.float32),
        "mem": jax.random.normal(next(ks), (BATCH, MEM_LEN, D), jnp.float32),
        "n_ffn1": gain((DEPTH, D)),
        "ffn1_w_gu": nrm((DEPTH, D, 2 * D_FF), D),
        "ffn1_w_down": nrm((DEPTH, D_FF, D), D_FF),
        "n_mix": gain((DEPTH, D)),
        "gla_w_in": nrm((N_GLA, D, 2 * GLA_KD + 2 * GLA_VD), D),
        "gla_w_g1": nrm((N_GLA, D, GATE_RANK), D),
        "gla_w_g2": nrm((N_GLA, GATE_RANK, GLA_KD), GATE_RANK),
        "gla_b_g": small((N_GLA, GLA_KD)),
        "gla_onorm": gain((N_GLA, GLA_DV)),
        "gla_w_out": nrm((N_GLA, GLA_VD, D), GLA_VD),
        "pool_w": nrm((N_POOL, POOL_GROUPS, POOL_GC, POOL_GC), POOL_GC),
        "pool_b": small((N_POOL, POOL_GROUPS, POOL_GC)),
        "pool_scale": gain((N_POOL, D)),
        "n_xattn": gain((DEPTH, D)),
        "n_mem": gain((DEPTH, D)),
        "x_w_q": nrm((DEPTH, D, D), D),
        "x_w_kv": nrm((DEPTH, D, 2 * D), D),
        "x_w_o": nrm((DEPTH, D, D), D),
        "n_ffn2": gain((DEPTH, D)),
        "ffn2_w_gu": nrm((DEPTH, D, 2 * D_FF), D),
        "ffn2_w_down": nrm((DEPTH, D_FF, D), D_FF),
        "n_final": gain((D,)),
    }


def reference(x, mem, n_ffn1, ffn1_w_gu, ffn1_w_down, n_mix, gla_w_in, gla_w_g1,
              gla_w_g2, gla_b_g, gla_onorm, gla_w_out, pool_w, pool_b, pool_scale,
              n_xattn, n_mem, x_w_q, x_w_kv, x_w_o, n_ffn2, ffn2_w_gu, ffn2_w_down,
              n_final):
    for i in range(DEPTH):
        x = x + 0.5 * swiglu_ffn(rmsnorm(x, n_ffn1[i]), ffn1_w_gu[i], ffn1_w_down[i])
        h = rmsnorm(x, n_mix[i])
        j = i // N_MIXERS
        if i % N_MIXERS == 0:
            mix = gla_mixer(h, gla_w_in[j], gla_w_g1[j], gla_w_g2[j], gla_b_g[j],
                            gla_onorm[j], gla_w_out[j])
        else:
            mix = pool_mixer(h, pool_w[j], pool_b[j], pool_scale[j])
        x = x + mix
        x = x + mem_cross_attn(rmsnorm(x, n_xattn[i]), rmsnorm(mem, n_mem[i]),
                               x_w_q[i], x_w_kv[i], x_w_o[i])
        x = x + 0.5 * swiglu_ffn(rmsnorm(x, n_ffn2[i]), ffn2_w_gu[i], ffn2_w_down[i])
    return rmsnorm(x, n_final)
```

```cpp
#include <hip/hip_runtime.h>
#include <hip/hip_cooperative_groups.h>
#include <cstdint>
#include <cstdio>
namespace cg = cooperative_groups;

#define LAS __attribute__((address_space(3)))
typedef unsigned short bf16_t;
typedef short bf16x8 __attribute__((ext_vector_type(8)));
typedef float f32x4 __attribute__((ext_vector_type(4)));
typedef unsigned u32x4 __attribute__((ext_vector_type(4)));
typedef unsigned u32x2 __attribute__((ext_vector_type(2)));

constexpr int T = 32768, DM = 1024, FF = 2816, NGU = 5632, SEQ = 4096, NPROJ = 3072, NPROJP = 3328;
constexpr float EPS = 1e-6f;
constexpr size_t MiB = 1u << 20;
constexpr size_t WS_WGU1 = 1 * MiB, WS_WGU2 = 12 * MiB, WS_WD1 = 23 * MiB, WS_WD2 = 29 * MiB, WS_WIN = 35 * MiB, WS_WOUT = 41 * MiB + MiB / 2,
                 WS_WPOOL = 43 * MiB, WS_WQ = 44 * MiB, WS_WKV = 46 * MiB, WS_WO = 50 * MiB, WS_MEMN = 52 * MiB, WS_KM = 56 * MiB, WS_VT = 60 * MiB,
                 WS_T16 = 64 * MiB, WS_DEC = 66 * MiB, WS_XN = 68 * MiB, WS_BIG = 132 * MiB, WS_SSQP = 452 * MiB, WS_WKV4 = 454 * MiB, WS_KM4 = 470 * MiB, WS_VT4 = 486 * MiB, WS_END = 502 * MiB;
constexpr size_t WS_ACT = WS_BIG, WS_PROJ = WS_BIG, WS_KVS = WS_BIG + 192 * MiB, WS_Q = WS_BIG, WS_P = WS_BIG + 64 * MiB, WS_O = WS_BIG + 128 * MiB,
                 WS_HF = WS_BIG, WS_PG = WS_BIG + 128 * MiB;
constexpr int LDS_BYTES = 147456;
constexpr int SMX_OFF = 131072, BARST_OFF = 131072 + 8192;

typedef float f32x2 __attribute__((ext_vector_type(2)));
typedef __bf16 bf16x2_t __attribute__((ext_vector_type(2)));
__device__ __forceinline__ unsigned cvt_pk_bf16(float lo, float hi) { const f32x2 v = {lo, hi}; const bf16x2_t b = __builtin_convertvector(v, bf16x2_t); return __builtin_bit_cast(unsigned, b); }
__device__ __forceinline__ float bf2f(unsigned v) { return __uint_as_float(v << 16); }
__device__ __forceinline__ float bflo(unsigned v) { return __uint_as_float(v << 16); }
__device__ __forceinline__ float bfhi(unsigned v) { return __uint_as_float(v & 0xffff0000u); }
__device__ __forceinline__ float silu_f(float g) { return g * __builtin_amdgcn_rcpf(1.f + __expf(-g)); }
__device__ __forceinline__ void silu2(float ga, float gb, float& sa, float& sb) {
    const float da = 1.f + __expf(-fmaxf(ga, -40.f)), db = 1.f + __expf(-fmaxf(gb, -40.f)), r = __builtin_amdgcn_rcpf(da * db);
    sa = ga * (r * db); sb = gb * (r * da);
}
__device__ __forceinline__ float shx(float v, int mask, int lane) { return __builtin_bit_cast(float, __builtin_amdgcn_ds_bpermute((lane ^ mask) << 2, __builtin_bit_cast(int, v))); }
__device__ __forceinline__ float shl_(float v, int src, int lane) { (void)lane; return __builtin_bit_cast(float, __builtin_amdgcn_ds_bpermute(src << 2, __builtin_bit_cast(int, v))); }
__device__ __forceinline__ float wave_sum(float v, int lane) {
#pragma unroll
    for (int o = 1; o < 64; o <<= 1) v += shx(v, o, lane);
    return v;
}

namespace pg8 {
constexpr int BM = 256, BK = 64, HALF = 128, HTB = HALF * BK * 2, STAGE_BYTES = 8 * HTB, NXCD = 8, WGM = 8;
__host__ __device__ __forceinline__ int lds_byte(int r, int c) { const int st = (r >> 4) * 2 + (c >> 5), rr = r & 15, cc = c & 31, ob = rr * 64 + cc * 2; return st * 1024 + (ob ^ (((ob >> 9) & 1) << 5)); }
__host__ __device__ __forceinline__ void stage_rc(int b, int& R, int& C) { const int st = b / 1024, sb = b % 1024, swz = sb ^ (((sb >> 9) & 1) << 5); R = (st >> 1) * 16 + swz / 64; C = (st & 1) * 32 + (swz % 64) / 2; }
__host__ __device__ __forceinline__ int perm32(int rho) { const int n = rho >> 4, i = rho & 15; return 8 * (i >> 2) + 4 * n + (i & 3); }

struct Unit { int pm, pn; };
struct Gemm { const bf16_t* A; const bf16_t* Bt; int M, N, K, lda, ldb; long a_pm, a_pn, b_pb, b_pn; int mode; };
__device__ __forceinline__ Gemm mk_gemm(const bf16_t* A, int lda, const bf16_t* Bt, int ldb, int M, int N, int K) {
    Gemm g; g.A = A; g.Bt = Bt; g.M = M; g.N = N; g.K = K; g.lda = lda; g.ldb = ldb; g.a_pm = (long)BM * lda * 2; g.a_pn = 0; g.b_pb = 0; g.b_pn = (long)BM * ldb * 2; g.mode = 0; return g;
}

__device__ __forceinline__ const char* unit_a(const Gemm& g, const Unit& u) {
    if (g.mode == 1) return (const char*)g.A + (size_t)(u.pm >> 2) * (256 * 1024 * 2) + (size_t)(u.pm & 3) * 512;
    if (g.mode == 2) return (const char*)g.A + (size_t)(u.pm & 3) * (256 * 1024 * 2) + (size_t)u.pn * 512;
    return (const char*)g.A + (size_t)u.pm * g.a_pm + (size_t)u.pn * g.a_pn;
}
__device__ __forceinline__ const char* unit_b(const Gemm& g, const Unit& u) {
    if (g.mode == 1) return (const char*)g.Bt + (size_t)u.pn * (256 * 1024 * 2) + (size_t)(u.pm & 3) * 512;
    if (g.mode == 2) return (const char*)g.Bt + (size_t)(u.pm >> 2) * (256 * 1024 * 2) + (size_t)u.pn * 512;
    return (const char*)g.Bt + (size_t)(u.pm >> 4) * g.b_pb + (size_t)u.pn * g.b_pn;
}
struct StaticOrder {
    int nM, nN, nwg, G, c;
    __device__ void init(int M, int N, int G_, int c_) { nM = M / BM; nN = N / BM; nwg = nM * nN; G = G_; c = c_; }
    __device__ bool next(int i, Unit& u) const {
        const long L = (long)i * G + c; if (L >= nwg) return false;
        int wgid = (int)L; { const int q = nwg / NXCD, r = nwg % NXCD, xcd = wgid % NXCD, off = wgid / NXCD; wgid = (xcd < r ? xcd * (q + 1) : r * (q + 1) + (xcd - r) * q) + off; }
        const int nig = WGM * nN, gid = wgid / nig, fm = gid * WGM, gsz = (nM - fm) < WGM ? (nM - fm) : WGM;
        u.pm = fm + ((wgid % nig) % gsz); u.pn = (wgid % nig) / gsz; return true;
    }
};

__device__ __forceinline__ float row_rs(const float* ssqp, int row) {
    const f32x4* q = (const f32x4*)(ssqp + (size_t)row * 16); const f32x4 a = q[0], b = q[1], c = q[2], d = q[3];
    const float s = ((a[0] + a[1]) + (a[2] + a[3])) + ((b[0] + b[1]) + (b[2] + b[3])) + ((c[0] + c[1]) + (c[2] + c[3])) + ((d[0] + d[1]) + (d[2] + d[3]));
    return 1.0f / sqrtf(s * (1.0f / DM) + EPS);
}
__device__ __forceinline__ void fill_rsc(LAS float* RSC, const float* ssqp, float scale, const Unit& u, int wr, int wc, int fr, int fq) {
    const int t_ = (wr * 4 + wc) * 64 + fq * 16 + fr;
    if (t_ < 256) RSC[t_] = scale * row_rs(ssqp, u.pm * BM + t_);
    asm volatile("s_waitcnt lgkmcnt(0)" ::: "memory"); __builtin_amdgcn_s_barrier(); asm volatile("" ::: "memory");
}
struct EpiBf16 {
    bf16_t* O; int ldc; float scale; const float* ssqp; float* t16; LAS float* RSC;
    __device__ __forceinline__ void operator()(f32x4 (&acc)[2][2][4][2], const Unit& u, int wr, int wc, int fr, int fq) const {
        const int row0 = u.pm * BM + wr * 64 + fr, col0 = u.pn * BM + wc * 32 + 8 * fq;
        const bool gate_tile = (t16 != nullptr) && (u.pn == 12);
        if (ssqp) fill_rsc(RSC, ssqp, scale, u, wr, wc, fr, fq);
#pragma unroll
        for (int ai = 0; ai < 2; ++ai)
#pragma unroll
            for (int m = 0; m < 4; ++m) { const int row = row0 + ai * HALF + m * 16; bf16_t* rowp = O + (size_t)row * ldc + col0;
                const float sc = ssqp ? RSC[ai * HALF + wr * 64 + m * 16 + fr] : scale;
                if (gate_tile) { if (wc == 0 && fq < 2) { *(f32x4*)(t16 + (size_t)row * 16 + 8 * fq) = acc[ai][0][m][0] * sc; *(f32x4*)(t16 + (size_t)row * 16 + 8 * fq + 4) = acc[ai][0][m][1] * sc; } continue; }
#pragma unroll
                for (int bj = 0; bj < 2; ++bj) { const f32x4 v0 = acc[ai][bj][m][0] * sc, v1 = acc[ai][bj][m][1] * sc; u32x4 w;
                    w.x = cvt_pk_bf16(v0[0], v0[1]); w.y = cvt_pk_bf16(v0[2], v0[3]); w.z = cvt_pk_bf16(v1[0], v1[1]); w.w = cvt_pk_bf16(v1[2], v1[3]);
                    *(u32x4*)(rowp + bj * HALF) = w; } }
    }
};
struct EpiSwiglu {
    bf16_t* O; const float* ssqp; LAS float* RSC;
    __device__ __forceinline__ void operator()(f32x4 (&acc)[2][2][4][2], const Unit& u, int wr, int wc, int fr, int fq) const {
        const int row0 = u.pm * BM + wr * 64 + fr, col0 = u.pn * HALF + wc * 32 + 8 * fq;
        fill_rsc(RSC, ssqp, 1.0f, u, wr, wc, fr, fq);
#pragma unroll
        for (int ai = 0; ai < 2; ++ai)
#pragma unroll
            for (int m = 0; m < 4; ++m) { const int row = row0 + ai * HALF + m * 16; bf16_t* rowp = O + (size_t)row * FF + col0;
                const float rs = RSC[ai * HALF + wr * 64 + m * 16 + fr];
                const f32x4 g0 = acc[ai][0][m][0] * rs, g1 = acc[ai][0][m][1] * rs, u0 = acc[ai][1][m][0] * rs, u1 = acc[ai][1][m][1] * rs; u32x4 w;
                float s0, s1, s2, s3, s4, s5, s6, s7;
                silu2(g0[0], g0[1], s0, s1); silu2(g0[2], g0[3], s2, s3); silu2(g1[0], g1[1], s4, s5); silu2(g1[2], g1[3], s6, s7);
                w.x = cvt_pk_bf16(s0 * u0[0], s1 * u0[1]); w.y = cvt_pk_bf16(s2 * u0[2], s3 * u0[3]);
                w.z = cvt_pk_bf16(s4 * u1[0], s5 * u1[1]); w.w = cvt_pk_bf16(s6 * u1[2], s7 * u1[3]);
                *(u32x4*)rowp = w; }
    }
};
struct EpiResid {
    const bf16_t* base; bf16_t* out; float alpha; const float* bias; const float* cscale; float* ssqp;
    template <bool HAS_BIAS>
    __device__ __forceinline__ void quarter(f32x4 (&acc)[2][2][4][2], const Unit& u, const int ai, const int mp, int wr, int wc, int fr, int fq) const {
        const int row0 = u.pm * BM + wr * 64 + fr + ai * HALF, col0 = u.pn * BM + wc * 32 + 8 * fq;
        u32x4 bw[2][2];
#pragma unroll
        for (int mm = 0; mm < 2; ++mm)
#pragma unroll
            for (int bj = 0; bj < 2; ++bj) bw[mm][bj] = *(const u32x4*)(base + (unsigned)((row0 + (2 * mp + mm) * 16) * DM + col0 + bj * HALF));
        asm volatile("" ::: "memory");
#pragma unroll
        for (int mm = 0; mm < 2; ++mm) { const int m = 2 * mp + mm, row = row0 + m * 16; const unsigned off = (unsigned)(row * DM + col0); float ss = 0.f;
#pragma unroll
            for (int bj = 0; bj < 2; ++bj) {
                f32x4 d0 = acc[ai][bj][m][0], d1 = acc[ai][bj][m][1];
                if (HAS_BIAS) { const f32x4 b0 = *(const f32x4*)(bias + col0 + bj * HALF), b1 = *(const f32x4*)(bias + col0 + bj * HALF + 4), s0 = *(const f32x4*)(cscale + col0 + bj * HALF), s1 = *(const f32x4*)(cscale + col0 + bj * HALF + 4);
                    d0 = (d0 + b0) * s0; d1 = (d1 + b1) * s1; }
                const f32x4 x0 = (f32x4){bflo(bw[mm][bj].x), bfhi(bw[mm][bj].x), bflo(bw[mm][bj].y), bfhi(bw[mm][bj].y)} + d0 * alpha;
                const f32x4 x1 = (f32x4){bflo(bw[mm][bj].z), bfhi(bw[mm][bj].z), bflo(bw[mm][bj].w), bfhi(bw[mm][bj].w)} + d1 * alpha;
                ss += ((x0[0] * x0[0] + x0[1] * x0[1]) + (x0[2] * x0[2] + x0[3] * x0[3])) + ((x1[0] * x1[0] + x1[1] * x1[1]) + (x1[2] * x1[2] + x1[3] * x1[3]));
                u32x4 w; w.x = cvt_pk_bf16(x0[0], x0[1]); w.y = cvt_pk_bf16(x0[2], x0[3]); w.z = cvt_pk_bf16(x1[0], x1[1]); w.w = cvt_pk_bf16(x1[2], x1[3]);
                *(u32x4*)(out + off + bj * HALF) = w; }
            ss += shx(ss, 16, fq * 16 + fr); ss += shx(ss, 32, fq * 16 + fr);
            if (ssqp != nullptr && fq == 0) ssqp[(size_t)row * 16 + 4 * u.pn + wc] = ss; }
    }
    __device__ __forceinline__ void operator()(f32x4 (&acc)[2][2][4][2], const Unit& u, int wr, int wc, int fr, int fq) const {
        if (bias) { quarter<true>(acc, u, 0, 0, wr, wc, fr, fq); quarter<true>(acc, u, 0, 1, wr, wc, fr, fq); quarter<true>(acc, u, 1, 0, wr, wc, fr, fq); quarter<true>(acc, u, 1, 1, wr, wc, fr, fq); }
        else { quarter<false>(acc, u, 0, 0, wr, wc, fr, fq); quarter<false>(acc, u, 0, 1, wr, wc, fr, fq); quarter<false>(acc, u, 1, 0, wr, wc, fr, fq); quarter<false>(acc, u, 1, 1, wr, wc, fr, fq); }
    }
};
struct EpiSoftmax {
    bf16_t* O; LAS unsigned char* tab; const float* ssqp; float scale;
    __device__ __forceinline__ void operator()(f32x4 (&acc)[2][2][4][2], const Unit& u, int wr, int wc, int fr, int fq) const {
        LAS float* MX = (LAS float*)tab; LAS float* SM = (LAS float*)(tab + 4096);
        LAS float* RSC = (LAS float*)(tab + 8192 + 256);
        fill_rsc(RSC, ssqp, scale, u, wr, wc, fr, fq);
#pragma unroll
        for (int ai = 0; ai < 2; ++ai)
#pragma unroll
            for (int m = 0; m < 4; ++m) { const float sc = RSC[ai * HALF + wr * 64 + m * 16 + fr];
#pragma unroll
                for (int bj = 0; bj < 2; ++bj)
#pragma unroll
                    for (int n = 0; n < 2; ++n) acc[ai][bj][m][n] = acc[ai][bj][m][n] * sc; }
#pragma unroll
        for (int ai = 0; ai < 2; ++ai)
#pragma unroll
            for (int m = 0; m < 4; ++m) { float mx = -3.0e38f;
#pragma unroll
                for (int bj = 0; bj < 2; ++bj)
#pragma unroll
                    for (int n = 0; n < 2; ++n) { const f32x4 x = acc[ai][bj][m][n]; mx = fmaxf(mx, fmaxf(fmaxf(x[0], x[1]), fmaxf(x[2], x[3]))); }
                mx = fmaxf(mx, shx(mx, 16, fq * 16 + fr)); mx = fmaxf(mx, shx(mx, 32, fq * 16 + fr));
                if (fq == 0) MX[(ai * HALF + wr * 64 + m * 16 + fr) * 4 + wc] = mx; }
        asm volatile("s_waitcnt lgkmcnt(0)" ::: "memory"); __builtin_amdgcn_s_barrier(); asm volatile("" ::: "memory");
#pragma unroll
        for (int ai = 0; ai < 2; ++ai)
#pragma unroll
            for (int m = 0; m < 4; ++m) { const int r = ai * HALF + wr * 64 + m * 16 + fr; const f32x4 t = *(LAS f32x4*)(MX + r * 4);
                const float mx = fmaxf(fmaxf(t[0], t[1]), fmaxf(t[2], t[3])); float s = 0.f;
#pragma unroll
                for (int bj = 0; bj < 2; ++bj)
#pragma unroll
                    for (int n = 0; n < 2; ++n) { f32x4 x = acc[ai][bj][m][n]; x[0] = __expf(x[0] - mx); x[1] = __expf(x[1] - mx); x[2] = __expf(x[2] - mx); x[3] = __expf(x[3] - mx);
                        acc[ai][bj][m][n] = x; s += (x[0] + x[1]) + (x[2] + x[3]); }
                s += shx(s, 16, fq * 16 + fr); s += shx(s, 32, fq * 16 + fr);
                if (fq == 0) SM[r * 4 + wc] = s; }
        asm volatile("s_waitcnt lgkmcnt(0)" ::: "memory"); __builtin_amdgcn_s_barrier(); asm volatile("" ::: "memory");
        const int row0 = u.pm * BM + wr * 64 + fr, col0 = u.pn * BM + wc * 32 + 8 * fq;
#pragma unroll
        for (int ai = 0; ai < 2; ++ai)
#pragma unroll
            for (int m = 0; m < 4; ++m) { const int r = ai * HALF + wr * 64 + m * 16 + fr; const f32x4 t = *(LAS f32x4*)(SM + r * 4);
                const float inv = 1.0f / ((t[0] + t[1]) + (t[2] + t[3])); bf16_t* rowp = O + (size_t)(row0 + ai * HALF + m * 16) * DM + col0;
#pragma unroll
                for (int bj = 0; bj < 2; ++bj) { const f32x4 v0 = acc[ai][bj][m][0] * inv, v1 = acc[ai][bj][m][1] * inv; u32x4 w;
                    w.x = cvt_pk_bf16(v0[0], v0[1]); w.y = cvt_pk_bf16(v0[2], v0[3]); w.z = cvt_pk_bf16(v1[0], v1[1]); w.w = cvt_pk_bf16(v1[2], v1[3]);
                    *(u32x4*)(rowp + bj * HALF) = w; } }
    }
};

template <class Epi>
__device__ __forceinline__ void gemm_phase(LAS unsigned char* lds, const Gemm g, const StaticOrder& S, const Epi& E, const int tid) {
    const int wid = __builtin_amdgcn_readfirstlane(tid >> 6), lane = tid & 63, wr = wid >> 2, wc = wid & 3, fr = lane & 15, fq = lane >> 4;
    const int K = g.K, nt = K / BK;
    unsigned voffA[2], voffB[2];
#pragma unroll
    for (int i = 0; i < 2; ++i) { int R, C; stage_rc(tid * 16 + i * 8192, R, C); const int Rb = (R & ~31) + perm32(R & 31);
        voffA[i] = (unsigned)(R * g.lda + C) * 2u; voffB[i] = (unsigned)(Rb * g.ldb + C) * 2u; }
    const size_t kstep = (size_t)(BK * 2);
    const size_t hA = (size_t)HALF * g.lda * 2, hB = (size_t)HALF * g.ldb * 2;
    const unsigned ldsw = (unsigned)wid * 1024u;
    const int aoff = lds_byte(wr * 64 + fr, fq * 8), boff = lds_byte(wc * 32 + fr, fq * 8);
#define PG8_SA(b, h) (((b) * 2 + (h)) * HTB)
#define PG8_SB(b, h) ((4 + (b) * 2 + (h)) * HTB)
#define PG8_STAGE(bufoff, gbase, voff) do { _Pragma("unroll") for (int _i = 0; _i < 2; ++_i) \
        __builtin_amdgcn_global_load_lds((const unsigned*)((const char*)(gbase) + (voff)[_i]), (LAS unsigned*)(lds + (bufoff) + ldsw + _i * 8192), 16, 0, 0); } while (0)
#define PG8_LDA(dst, b, h) do { _Pragma("unroll") for (int m = 0; m < 4; ++m) _Pragma("unroll") for (int k = 0; k < 2; ++k) dst[m][k] = *(const LAS bf16x8*)(lds + PG8_SA(b, h) + aoff + m * 2048 + k * 1024); } while (0)
#define PG8_LDB(dst, b, h) do { _Pragma("unroll") for (int n = 0; n < 2; ++n) _Pragma("unroll") for (int k = 0; k < 2; ++k) dst[n][k] = *(const LAS bf16x8*)(lds + PG8_SB(b, h) + boff + n * 2048 + k * 1024); } while (0)
#define PG8_MMA(ai, bj, At, Bt) do { __builtin_amdgcn_s_setprio(1); _Pragma("unroll") for (int m = 0; m < 4; ++m) _Pragma("unroll") for (int n = 0; n < 2; ++n) _Pragma("unroll") for (int k = 0; k < 2; ++k) \
        acc[ai][bj][m][n] = __builtin_amdgcn_mfma_f32_16x16x32_bf16(Bt[n][k], At[m][k], acc[ai][bj][m][n], 0, 0, 0); __builtin_amdgcn_s_setprio(0); } while (0)
#define PG8_WAIT_V(n) asm volatile("s_waitcnt vmcnt(" #n ")" ::: "memory")
#define PG8_WAIT_L(n) asm volatile("s_waitcnt lgkmcnt(" #n ")" ::: "memory")
#define PG8_BAR __builtin_amdgcn_s_barrier()
#define PG8_SCHED __builtin_amdgcn_sched_barrier(0)
#define PG8_UA(u) unit_a(g, u)
#define PG8_UB(u) unit_b(g, u)
    Unit cur, nxt; int ui = 0;
    if (!S.next(0, cur)) return;
    f32x4 acc[2][2][4][2];
#pragma unroll
    for (int a = 0; a < 2; ++a)
#pragma unroll
        for (int b = 0; b < 2; ++b)
#pragma unroll
            for (int m = 0; m < 4; ++m)
#pragma unroll
                for (int n = 0; n < 2; ++n) acc[a][b][m][n] = (f32x4){0.f, 0.f, 0.f, 0.f};
    bf16x8 At[4][2], B0[2][2], B1[2][2];
    const char* cA = PG8_UA(cur); const char* cB = PG8_UB(cur);
    PG8_STAGE(PG8_SB(0, 0), cB, voffB); PG8_STAGE(PG8_SB(0, 1), cB + hB, voffB); PG8_STAGE(PG8_SA(0, 0), cA, voffA); PG8_STAGE(PG8_SA(0, 1), cA + hA, voffA);
    if (wr == 1) PG8_BAR;
    PG8_WAIT_V(2); PG8_BAR;
    PG8_STAGE(PG8_SB(1, 0), cB + kstep, voffB); PG8_STAGE(PG8_SA(1, 0), cA + kstep, voffA); PG8_STAGE(PG8_SB(1, 1), cB + hB + kstep, voffB);
    PG8_WAIT_V(6); PG8_BAR;
    for (;;) {
        const bool has_next = S.next(ui + 1, nxt);
        const char* nA = has_next ? PG8_UA(nxt) : cA; const char* nB = has_next ? PG8_UB(nxt) : cB;
        for (int t = 0; t < nt; t += 2) {
            const bool last = (t == nt - 2);
            const char* a1 = cA + (size_t)(t + 1) * kstep;
            const char* a2 = last ? nA : cA + (size_t)(t + 2) * kstep; const char* b2 = last ? nB : cB + (size_t)(t + 2) * kstep;
            const char* a3 = a2 + kstep; const char* b3 = b2 + kstep;
            PG8_LDB(B0, 0, 0); PG8_LDB(B1, 0, 1); PG8_SCHED; PG8_LDA(At, 0, 0); PG8_STAGE(PG8_SA(1, 1), a1 + hA, voffA);
            PG8_WAIT_V(8); PG8_WAIT_L(0); PG8_BAR; PG8_MMA(0, 0, At, B0); PG8_MMA(0, 1, At, B1); PG8_BAR; PG8_SCHED;
            PG8_LDA(At, 0, 1); PG8_STAGE(PG8_SB(0, 0), b2, voffB); PG8_STAGE(PG8_SB(0, 1), b2 + hB, voffB); PG8_STAGE(PG8_SA(0, 0), a2, voffA);
            PG8_WAIT_V(8); PG8_WAIT_L(0); PG8_BAR; PG8_MMA(1, 0, At, B0); PG8_MMA(1, 1, At, B1); PG8_BAR; PG8_SCHED;
            PG8_LDB(B0, 1, 0); PG8_LDB(B1, 1, 1); PG8_SCHED; PG8_LDA(At, 1, 0); PG8_STAGE(PG8_SA(0, 1), a2 + hA, voffA);
            PG8_WAIT_V(8); PG8_WAIT_L(0); PG8_BAR; PG8_MMA(0, 0, At, B0); PG8_MMA(0, 1, At, B1); PG8_BAR; PG8_SCHED;
            PG8_LDA(At, 1, 1); PG8_STAGE(PG8_SB(1, 0), b3, voffB); PG8_STAGE(PG8_SB(1, 1), b3 + hB, voffB); PG8_STAGE(PG8_SA(1, 0), a3, voffA);
            PG8_WAIT_V(8); PG8_WAIT_L(0); PG8_BAR; PG8_MMA(1, 0, At, B0); PG8_MMA(1, 1, At, B1); PG8_BAR; PG8_SCHED;
        }
        if (wr == 0) PG8_BAR;
        E(acc, cur, wr, wc, fr, fq);
        if (!has_next) break;
#pragma unroll
        for (int a = 0; a < 2; ++a)
#pragma unroll
            for (int b = 0; b < 2; ++b)
#pragma unroll
                for (int m = 0; m < 4; ++m)
#pragma unroll
                    for (int n = 0; n < 2; ++n) acc[a][b][m][n] = (f32x4){0.f, 0.f, 0.f, 0.f};
        cur = nxt; cA = nA; cB = nB; ++ui;
        if (wr == 1) PG8_BAR;
    }
    PG8_WAIT_V(0);
    PG8_BAR;
#undef PG8_SA
#undef PG8_SB
#undef PG8_STAGE
#undef PG8_LDA
#undef PG8_LDB
#undef PG8_MMA
#undef PG8_WAIT_V
#undef PG8_WAIT_L
#undef PG8_BAR
#undef PG8_SCHED
#undef PG8_UA
#undef PG8_UB
}
}

__device__ __forceinline__ void norm_phase(const float* xin, const float* gain, bf16_t* xn, float* fout, const float* wg1, float* t16, const int MODE, int nrows, int gw, int ngw, int lane) {
#pragma unroll 4
    for (int row = gw; row < nrows; row += ngw) {
        const f32x4* xr = (const f32x4*)(xin + (size_t)row * DM) + lane;
        f32x4 v[4]; float s = 0.f;
#pragma unroll
        for (int j = 0; j < 4; ++j) { v[j] = xr[64 * j]; s += (v[j][0] * v[j][0] + v[j][1] * v[j][1]) + (v[j][2] * v[j][2] + v[j][3] * v[j][3]); }
        s = wave_sum(s, lane);
        if (MODE == 3) { if (lane < 16) t16[(size_t)row * 16 + lane] = lane == 0 ? s : 0.f; }
        else {
        const float rs = 1.0f / sqrtf(s * (1.0f / DM) + EPS);
#pragma unroll
        for (int j = 0; j < 4; ++j) { const f32x4 gg = gain ? ((const f32x4*)gain)[lane + 64 * j] : (f32x4){1.f, 1.f, 1.f, 1.f}; v[j] = v[j] * rs * gg; }
        }
        if (MODE == 2) {
            f32x4* o = (f32x4*)(fout + (size_t)row * DM) + lane;
#ifdef DBG_STOP
#pragma unroll
            for (int j = 0; j < 4; ++j)
#pragma unroll
                for (int e = 0; e < 4; ++e) if (!(fabsf(v[j][e]) < 1e30f)) v[j][e] = 1e6f;
#endif
#pragma unroll
            for (int j = 0; j < 4; ++j) o[64 * j] = v[j];
        } else {
            u32x2* o = (u32x2*)(xn + (size_t)row * DM) + lane;
#pragma unroll
            for (int j = 0; j < 4; ++j) { u32x2 w; w.x = cvt_pk_bf16(v[j][0], v[j][1]); w.y = cvt_pk_bf16(v[j][2], v[j][3]); o[64 * j] = w; }
        }
        if (MODE == 1) {
            f32x4 a[4];
#pragma unroll
            for (int q = 0; q < 4; ++q) a[q] = (f32x4){0.f, 0.f, 0.f, 0.f};
#pragma unroll
            for (int j = 0; j < 4; ++j)
#pragma unroll
                for (int e = 0; e < 4; ++e) { const f32x4* wp = (const f32x4*)(wg1 + (size_t)(4 * (lane + 64 * j) + e) * 16); const float hv = v[j][e];
#pragma unroll
                    for (int q = 0; q < 4; ++q) a[q] += wp[q] * hv; }
            float outv = 0.f;
#pragma unroll
            for (int q = 0; q < 4; ++q)
#pragma unroll
                for (int e = 0; e < 4; ++e) { const float sres = wave_sum(a[q][e], lane); if (lane == q * 4 + e) outv = sres; }
            if (lane < 16) t16[(size_t)row * 16 + lane] = outv;
        }
    }
}

__device__ __forceinline__ void final_norm(const bf16_t* xb, const float* gain, float* out, int gw, int ngw, int lane) {
#pragma unroll 4
    for (int row = gw; row < T; row += ngw) {
        const u32x4* xr = (const u32x4*)(xb + (size_t)row * DM) + 2 * lane;
        const u32x4 a = xr[0], b = xr[1];
        float v[16] = {bflo(a.x), bfhi(a.x), bflo(a.y), bfhi(a.y), bflo(a.z), bfhi(a.z), bflo(a.w), bfhi(a.w), bflo(b.x), bfhi(b.x), bflo(b.y), bfhi(b.y), bflo(b.z), bfhi(b.z), bflo(b.w), bfhi(b.w)};
        float s = 0.f;
#pragma unroll
        for (int e = 0; e < 16; ++e) s += v[e] * v[e];
        s = wave_sum(s, lane);
        const float rs = 1.0f / sqrtf(s * (1.0f / DM) + EPS);
        const f32x4* gp = (const f32x4*)(gain + 16 * lane); f32x4* op = (f32x4*)(out + (size_t)row * DM + 16 * lane);
#pragma unroll
        for (int q = 0; q < 4; ++q) { const f32x4 gg = gp[q]; op[q] = (f32x4){v[4 * q] * rs * gg[0], v[4 * q + 1] * rs * gg[1], v[4 * q + 2] * rs * gg[2], v[4 * q + 3] * rs * gg[3]}; }
    }
}

__device__ __forceinline__ void transpose_item(const float* W, int K, int N, bf16_t* WT, int k0, int n0, int drow0, LAS float* scr, int lane, const float* gain) {
    const float g0 = gain ? gain[k0 + lane] : 1.0f;
    float wv[32];
#pragma unroll
    for (int i = 0; i < 32; ++i) { const int kk = 2 * i + (lane >> 5); wv[i] = W[(size_t)(k0 + kk) * N + n0 + (lane & 31)]; }
#pragma unroll
    for (int i = 0; i < 32; ++i) { const int kk = 2 * i + (lane >> 5); scr[kk * 33 + (lane & 31)] = wv[i] * shl_(g0, kk, lane); }
    asm volatile("s_waitcnt lgkmcnt(0)" ::: "memory");
    const int c = lane & 7;
#pragma unroll
    for (int j = 0; j < 4; ++j) { const int n = (lane >> 3) + 8 * j; const LAS float* s = scr + (8 * c) * 33 + n;
        u32x4 o; o.x = cvt_pk_bf16(s[0 * 33], s[1 * 33]); o.y = cvt_pk_bf16(s[2 * 33], s[3 * 33]); o.z = cvt_pk_bf16(s[4 * 33], s[5 * 33]); o.w = cvt_pk_bf16(s[6 * 33], s[7 * 33]);
        *(u32x4*)(WT + (size_t)(drow0 + n) * K + k0 + 8 * c) = o; }
    asm volatile("s_waitcnt lgkmcnt(0)" ::: "memory");
}
__device__ __forceinline__ void convert_item(const float* W, bf16_t* WT, const float* gain, int it, int lane) {
    const size_t off = (size_t)it * 512 + lane * 8; const float gsc = gain[off >> 10];
    const f32x4 a = *(const f32x4*)(W + off) * gsc, b = *(const f32x4*)(W + off + 4) * gsc;
    u32x4 o; o.x = cvt_pk_bf16(a[0], a[1]); o.y = cvt_pk_bf16(a[2], a[3]); o.z = cvt_pk_bf16(b[0], b[1]); o.w = cvt_pk_bf16(b[2], b[3]);
    *(u32x4*)(WT + off) = o;
}
__device__ __forceinline__ bool prep_plain(int& it, const float* W, int K, int N, bf16_t* WT, LAS float* scr, int lane, const float* gain) {
    const int nblk = N / 32, items = (K / 64) * nblk;
    if (it >= items) { it -= items; return false; }
    const int kb = it / nblk, nb = it % nblk; transpose_item(W, K, N, WT, 64 * kb, 32 * nb, 32 * nb, scr, lane, gain); return true;
}
__device__ __forceinline__ bool prep_gu(int& it, const float* W, bf16_t* WT, LAS float* scr, int lane, const float* gain) {
    const int nblk = NGU / 32, items = (DM / 64) * nblk;
    if (it >= items) { it -= items; return false; }
    const int kb = it / nblk, nb = it % nblk, n0 = 32 * nb, half = n0 / FF, j = n0 % FF, drow = 256 * (j / 128) + 128 * half + (j % 128);
    transpose_item(W, DM, NGU, WT, 64 * kb, n0, drow, scr, lane, gain); return true;
}

__device__ __forceinline__ void pool_phase(LAS unsigned char* L, const bf16_t* X, const float* ssqp, const float* gain, bf16_t* PG, int blk, int G, int tid) {
    LAS float* RS = (LAS float*)L;
    for (int tb = blk * 128; tb < T; tb += G * 128) {
        __syncthreads();
        if (tid < 144) { const int t = tb - 16 + tid; RS[tid] = t >= 0 ? pg8::row_rs(ssqp, t) : 0.f; }
        __syncthreads();
        const int c4 = tid & 255, half = tid >> 8, g = c4 >> 6, w = 2 << g, ts = tb + half * 64, s0 = ts & (SEQ - 1);
        const f32x4 gg = ((const f32x4*)gain)[c4];
        const u32x2* xp = (const u32x2*)(X + (size_t)ts * DM) + c4;
#define LDX(idx) ({ const u32x2 _w = xp[idx]; (f32x4){bflo(_w.x), bfhi(_w.x), bflo(_w.y), bfhi(_w.y)}; })
        LAS float* rsp = RS + 16 + half * 64;
        f32x4 win = (f32x4){0.f, 0.f, 0.f, 0.f};
        const int npre = (w - 1) < s0 ? (w - 1) : s0;
        for (int j = 1; j <= npre; ++j) win += LDX(-256 * j) * rsp[-j];
        bf16_t* outp = PG + (size_t)g * T * 256 + (size_t)ts * 256 + (c4 & 63) * 4;
#pragma unroll 4
        for (int i = 0; i < 64; ++i) {
            const f32x4 hv = LDX(256 * i) * rsp[i]; win += hv;
            const int s = s0 + i; const int cnt = (s + 1) < w ? (s + 1) : w;
            const f32x4 r = (win * (1.0f / (float)cnt) - hv) * gg;
            if (s + 1 >= w) win -= LDX(256 * (i + 1 - w)) * rsp[i + 1 - w];
            u32x2 o; o.x = cvt_pk_bf16(r[0], r[1]); o.y = cvt_pk_bf16(r[2], r[3]);
            *(u32x2*)(outp + (size_t)i * 256) = o;
        }
    }
}

__device__ __forceinline__ float logsig(float z) { return fminf(z, 0.f) - __logf(1.f + __expf(-fabsf(z))); }

__device__ __forceinline__ void gla_pass1(LAS unsigned char* L, const bf16_t* PROJ, const float* T16, const float* wg2, const float* bg, float* Bbuf, bf16_t* KVS, float* DEC, int blk, int G, int tid) {
    LAS float* T16s = (LAS float*)L; LAS float* SEG = (LAS float*)(L + 4096); LAS float* BL = (LAS float*)(L + 8192);
    LAS bf16_t* KT = (LAS bf16_t*)(L + 40960); LAS bf16_t* VTs = (LAS bf16_t*)(L + 59392);
    const int lane = tid & 63, wid = tid >> 6, fr = lane & 15, fq = lane >> 4;
    const int dk = tid & 127, seg = tid >> 7, dv = tid & 255, th = tid >> 8;
    const int h = blk & 3;
    float w2[16];
#pragma unroll
    for (int r = 0; r < 16; ++r) w2[r] = wg2[r * 512 + h * 128 + dk];
    const float bgv = bg[h * 128 + dk];
    unsigned kraw[16], vraw[16]; f32x4 t16r = (f32x4){0.f, 0.f, 0.f, 0.f};
    const int rotk = (dk >> 3) & 3, rotv = (dv >> 3) & 3;
#define P1_LOAD(unit_) do { const int n_ = ((unit_) >> 2) & 63, b_ = (unit_) >> 8, t0_ = b_ * SEQ + n_ * 64; \
        _Pragma("unroll") for (int i = 0; i < 16; ++i) kraw[i] = PROJ[(size_t)(t0_ + seg * 16 + 2 * (((i >> 1) + rotk) & 7) + (i & 1)) * NPROJ + 512 + h * 128 + dk]; \
        _Pragma("unroll") for (int i = 0; i < 16; ++i) { const int tp_ = th * 32 + 2 * ((i + rotv) & 15); const unsigned v0 = PROJ[(size_t)(t0_ + tp_) * NPROJ + 1024 + h * 256 + dv], v1 = PROJ[(size_t)(t0_ + tp_ + 1) * NPROJ + 1024 + h * 256 + dv]; vraw[i] = v0 | (v1 << 16); } \
        if (tid < 256) t16r = ((const f32x4*)(T16 + (size_t)t0_ * 16))[tid]; } while (0)
    if (blk < 2048) P1_LOAD(blk);
    for (int unit = blk; unit < 2048; unit += G) {
        const int n = (unit >> 2) & 63, b = unit >> 8, t0 = b * SEQ + n * 64, cidx = (b * 4 + h) * 64 + n;
        __syncthreads();
        if (tid < 256) ((LAS f32x4*)T16s)[tid] = t16r;
        __syncthreads();
        float run = 0.f;
#pragma unroll 4
        for (int i = 0; i < 16; ++i) { const int tok = seg * 16 + i; float z = bgv;
#pragma unroll
            for (int r = 0; r < 16; ++r) z += T16s[tok * 16 + r] * w2[r];
            run += logsig(z) * (1.0f / 16.0f); BL[tok * 128 + dk] = run; }
        SEG[seg * 128 + dk] = run;
        __syncthreads();
        float offs = 0.f, total = 0.f;
#pragma unroll
        for (int s = 0; s < 4; ++s) { const float v = SEG[s * 128 + dk]; total += v; if (s < seg) offs += v; }
#pragma unroll
        for (int i = 0; i < 16; i += 2) { const int tok = seg * 16 + 2 * (((i >> 1) + rotk) & 7);
            const float b0 = BL[tok * 128 + dk] + offs, b1 = BL[(tok + 1) * 128 + dk] + offs;
            Bbuf[(size_t)(t0 + tok) * 512 + h * 128 + dk] = b0; Bbuf[(size_t)(t0 + tok + 1) * 512 + h * 128 + dk] = b1;
            const float k0 = bf2f(kraw[i]), k1 = bf2f(kraw[i + 1]);
            *(LAS unsigned*)(KT + dk * 72 + tok) = cvt_pk_bf16(k0 * __expf(total - b0), k1 * __expf(total - b1)); }
        if (seg == 0) DEC[(size_t)cidx * 128 + dk] = __expf(total);
#pragma unroll
        for (int i = 0; i < 16; ++i) *(LAS unsigned*)(VTs + dv * 72 + th * 32 + 2 * ((i + rotv) & 15)) = vraw[i];
        if (unit + G < 2048) P1_LOAD(unit + G);
        __syncthreads();
        bf16x8 X[2];
#pragma unroll
        for (int s = 0; s < 2; ++s) X[s] = *(const LAS bf16x8*)(KT + (16 * wid + fr) * 72 + 32 * s + 8 * fq);
#pragma unroll 4
        for (int nt = 0; nt < 16; ++nt) { f32x4 acc = (f32x4){0.f, 0.f, 0.f, 0.f};
#pragma unroll
            for (int s = 0; s < 2; ++s) { const bf16x8 Y = *(const LAS bf16x8*)(VTs + (16 * nt + fr) * 72 + 32 * s + 8 * fq); acc = __builtin_amdgcn_mfma_f32_16x16x32_bf16(X[s], Y, acc, 0, 0, 0); }
            u32x2 o; o.x = cvt_pk_bf16(acc[0], acc[1]); o.y = cvt_pk_bf16(acc[2], acc[3]);
            *(u32x2*)(KVS + ((size_t)cidx * 256 + 16 * nt + fr) * 128 + 16 * wid + 4 * fq) = o; }
    }
#undef P1_LOAD
}

__device__ __forceinline__ void gla_scan(bf16_t* KVS, const float* DEC, int gtid, int nthreads) {
    for (int item = gtid; item < 32 * 256 * 32; item += nthreads) {
        const int dk4 = item & 31, dv = (item >> 5) & 255, bh = item >> 13;
        bf16_t* p = KVS + ((size_t)bh * 64 * 256 + dv) * 128 + dk4 * 4;
        const float* d = DEC + (size_t)bh * 64 * 128 + dk4 * 4;
        f32x4 S = (f32x4){0.f, 0.f, 0.f, 0.f};
        for (int n0 = 0; n0 < 64; n0 += 16) {
            u32x2 kv[16]; f32x4 dc[16];
#pragma unroll
            for (int k = 0; k < 16; ++k) { kv[k] = *(const u32x2*)(p + (size_t)(n0 + k) * 32768); dc[k] = *(const f32x4*)(d + (n0 + k) * 128); }
#pragma unroll
            for (int k = 0; k < 16; ++k) { u32x2 o; o.x = cvt_pk_bf16(S[0], S[1]); o.y = cvt_pk_bf16(S[2], S[3]); *(u32x2*)(p + (size_t)(n0 + k) * 32768) = o;
                S[0] = dc[k][0] * S[0] + bflo(kv[k].x); S[1] = dc[k][1] * S[1] + bfhi(kv[k].x); S[2] = dc[k][2] * S[2] + bflo(kv[k].y); S[3] = dc[k][3] * S[3] + bfhi(kv[k].y); }
        }
    }
}

__device__ __forceinline__ void gla_pass3(LAS unsigned char* L, bf16_t* PROJ, const float* Bbuf, const bf16_t* KVS, const float* onorm, int blk, int G, int tid) {
    LAS bf16_t* QIN = (LAS bf16_t*)L; LAS bf16_t* QA = (LAS bf16_t*)(L + 17408); LAS bf16_t* KA = (LAS bf16_t*)(L + 34816);
    LAS bf16_t* VTs = (LAS bf16_t*)(L + 52224); LAS float* SSQ = (LAS float*)(L + 107520);
    const int lane = tid & 63, wid = tid >> 6, fr = lane & 15, fq = lane >> 4, rg = wid & 3, ch = wid >> 2;
    LAS bf16_t* AM = (LAS bf16_t*)(L + 89088 + wid * 2304);
    const int h = blk & 3;
    const int dv = tid & 255, th = tid >> 8, tok = tid >> 3, dkc = (tid & 7) * 16;
    unsigned vraw[16]; f32x4 bA[2], bB[2], rA[2], rB[2]; u32x4 q8[2], k8[2];
    const int rotv = (dv >> 3) & 3;
#define P3_LOAD(unit_) do { const int n_ = ((unit_) >> 2) & 63, b_ = (unit_) >> 8, t0_ = b_ * SEQ + n_ * 64; \
        _Pragma("unroll") for (int i = 0; i < 16; ++i) { const int tp_ = th * 32 + 2 * ((i + rotv) & 15); const unsigned v0 = PROJ[(size_t)(t0_ + tp_) * NPROJ + 1024 + h * 256 + dv], v1 = PROJ[(size_t)(t0_ + tp_ + 1) * NPROJ + 1024 + h * 256 + dv]; vraw[i] = v0 | (v1 << 16); } \
        const float* bp_ = Bbuf + (size_t)(t0_ + tok) * 512 + h * 128 + dkc; const float* brp_ = Bbuf + (size_t)(t0_ + 31) * 512 + h * 128 + dkc; const bf16_t* qp_ = PROJ + (size_t)(t0_ + tok) * NPROJ + h * 128 + dkc; \
        _Pragma("unroll") for (int c = 0; c < 2; ++c) { bA[c] = *(const f32x4*)(bp_ + 8 * c); bB[c] = *(const f32x4*)(bp_ + 8 * c + 4); rA[c] = *(const f32x4*)(brp_ + 8 * c); rB[c] = *(const f32x4*)(brp_ + 8 * c + 4); \
            q8[c] = *(const u32x4*)(qp_ + 8 * c); k8[c] = *(const u32x4*)(qp_ + 512 + 8 * c); } } while (0)
    if (blk < 2048) P3_LOAD(blk);
    for (int unit = blk; unit < 2048; unit += G) {
        const int n = (unit >> 2) & 63, b = unit >> 8, t0 = b * SEQ + n * 64, cidx = (b * 4 + h) * 64 + n;
        __syncthreads();
#pragma unroll
        for (int c = 0; c < 2; ++c) {
            float bv[8] = {bA[c][0], bA[c][1], bA[c][2], bA[c][3], bB[c][0], bB[c][1], bB[c][2], bB[c][3]}, rv[8] = {rA[c][0], rA[c][1], rA[c][2], rA[c][3], rB[c][0], rB[c][1], rB[c][2], rB[c][3]};
            float qv[8] = {bflo(q8[c].x), bfhi(q8[c].x), bflo(q8[c].y), bfhi(q8[c].y), bflo(q8[c].z), bfhi(q8[c].z), bflo(q8[c].w), bfhi(q8[c].w)};
            float kv[8] = {bflo(k8[c].x), bfhi(k8[c].x), bflo(k8[c].y), bfhi(k8[c].y), bflo(k8[c].z), bfhi(k8[c].z), bflo(k8[c].w), bfhi(k8[c].w)};
            float qi[8], qa[8], ka[8];
#pragma unroll
            for (int e = 0; e < 8; ++e) { const float qs = qv[e] * 0.08838834764831845f; qi[e] = qs * __expf(bv[e]); qa[e] = qs * __expf(bv[e] - rv[e]); ka[e] = kv[e] * __expf(rv[e] - bv[e]); }
            u32x4 w;
            w.x = cvt_pk_bf16(qi[0], qi[1]); w.y = cvt_pk_bf16(qi[2], qi[3]); w.z = cvt_pk_bf16(qi[4], qi[5]); w.w = cvt_pk_bf16(qi[6], qi[7]); *(LAS u32x4*)(QIN + tok * 136 + dkc + 8 * c) = w;
            w.x = cvt_pk_bf16(qa[0], qa[1]); w.y = cvt_pk_bf16(qa[2], qa[3]); w.z = cvt_pk_bf16(qa[4], qa[5]); w.w = cvt_pk_bf16(qa[6], qa[7]); *(LAS u32x4*)(QA + tok * 136 + dkc + 8 * c) = w;
            w.x = cvt_pk_bf16(ka[0], ka[1]); w.y = cvt_pk_bf16(ka[2], ka[3]); w.z = cvt_pk_bf16(ka[4], ka[5]); w.w = cvt_pk_bf16(ka[6], ka[7]); *(LAS u32x4*)(KA + tok * 136 + dkc + 8 * c) = w;
        }
#pragma unroll
        for (int i = 0; i < 16; ++i) *(LAS unsigned*)(VTs + dv * 72 + th * 32 + 2 * ((i + rotv) & 15)) = vraw[i];
        bf16x8 XS[4][4];
#pragma unroll
        for (int nt = 0; nt < 4; ++nt)
#pragma unroll
            for (int s = 0; s < 4; ++s) XS[nt][s] = *(const bf16x8*)(KVS + ((size_t)cidx * 256 + 16 * (8 * ch + nt) + fr) * 128 + 32 * s + 8 * fq);
        __syncthreads();
        bf16_t* rowp = PROJ + (size_t)(t0 + 16 * rg + fr) * NPROJ + h * 256;
        u32x2 r4v[8];
#pragma unroll
        for (int nt = 0; nt < 8; ++nt) r4v[nt] = *(const u32x2*)(rowp + 2048 + 16 * (8 * ch + nt) + 4 * fq);
        {
            bf16x8 Yq[4];
#pragma unroll
            for (int s = 0; s < 4; ++s) Yq[s] = *(const LAS bf16x8*)(QA + (16 * rg + fr) * 136 + 32 * s + 8 * fq);
#pragma unroll
            for (int jt = 0; jt < 4; ++jt) { f32x4 a = (f32x4){0.f, 0.f, 0.f, 0.f};
                if (jt <= rg) {
#pragma unroll
                    for (int s = 0; s < 4; ++s) { const bf16x8 X = *(const LAS bf16x8*)(KA + (16 * jt + fr) * 136 + 32 * s + 8 * fq); a = __builtin_amdgcn_mfma_f32_16x16x32_bf16(X, Yq[s], a, 0, 0, 0); }
                }
#pragma unroll
                for (int e = 0; e < 4; ++e) if (16 * jt + 4 * fq + e > 16 * rg + fr) a[e] = 0.f;
                u32x2 o; o.x = cvt_pk_bf16(a[0], a[1]); o.y = cvt_pk_bf16(a[2], a[3]);
                *(LAS u32x2*)(AM + fr * 72 + 16 * jt + 4 * fq) = o; }
        }
        asm volatile("s_waitcnt lgkmcnt(0)" ::: "memory");
        if (unit + G < 2048) P3_LOAD(unit + G);
        bf16x8 YA[2], YQ[4];
#pragma unroll
        for (int s = 0; s < 2; ++s) YA[s] = *(const LAS bf16x8*)(AM + fr * 72 + 32 * s + 8 * fq);
#pragma unroll
        for (int s = 0; s < 4; ++s) YQ[s] = *(const LAS bf16x8*)(QIN + (16 * rg + fr) * 136 + 32 * s + 8 * fq);
        f32x4 o[8]; float ssq = 0.f;
#pragma unroll
        for (int hf = 0; hf < 2; ++hf) {
#pragma unroll
            for (int q = 0; q < 4; ++q) { const int nt = 4 * hf + q, dvt = 8 * ch + nt; f32x4 acc = (f32x4){0.f, 0.f, 0.f, 0.f};
#pragma unroll
                for (int s = 0; s < 2; ++s) { const bf16x8 X = *(const LAS bf16x8*)(VTs + (16 * dvt + fr) * 72 + 32 * s + 8 * fq); acc = __builtin_amdgcn_mfma_f32_16x16x32_bf16(X, YA[s], acc, 0, 0, 0); }
#pragma unroll
                for (int s = 0; s < 4; ++s) acc = __builtin_amdgcn_mfma_f32_16x16x32_bf16(XS[q][s], YQ[s], acc, 0, 0, 0);
                o[nt] = acc; ssq += (acc[0] * acc[0] + acc[1] * acc[1]) + (acc[2] * acc[2] + acc[3] * acc[3]); }
            if (hf == 0) {
#pragma unroll
                for (int nt = 0; nt < 4; ++nt)
#pragma unroll
                    for (int s = 0; s < 4; ++s) XS[nt][s] = *(const bf16x8*)(KVS + ((size_t)cidx * 256 + 16 * (8 * ch + 4 + nt) + fr) * 128 + 32 * s + 8 * fq);
            }
        }
        ssq += shx(ssq, 16, lane); ssq += shx(ssq, 32, lane);
        if (fq == 0) SSQ[(16 * rg + fr) * 2 + ch] = ssq;
        __syncthreads();
        const float tot = SSQ[(16 * rg + fr) * 2] + SSQ[(16 * rg + fr) * 2 + 1];
        const float rs = 1.0f / sqrtf(tot * (1.0f / 256.0f) + EPS);
#pragma unroll
        for (int nt = 0; nt < 8; ++nt) { const int dv0 = 16 * (8 * ch + nt) + 4 * fq;
            const f32x4 g4 = *(const f32x4*)(onorm + dv0); const u32x2 r4 = r4v[nt];
            const float v0 = o[nt][0] * rs * g4[0] * silu_f(bflo(r4.x)), v1 = o[nt][1] * rs * g4[1] * silu_f(bfhi(r4.x)), v2 = o[nt][2] * rs * g4[2] * silu_f(bflo(r4.y)), v3 = o[nt][3] * rs * g4[3] * silu_f(bfhi(r4.y));
            u32x2 w; w.x = cvt_pk_bf16(v0, v1); w.y = cvt_pk_bf16(v2, v3);
            *(u32x2*)(rowp + 1024 + dv0) = w; }
    }
#undef P3_LOAD
}

#define XB_TMO      128
#define XB_XCNT(j)  (256  + 64 * (j))
#define XB_XSUB(j)  (1280 + 64 * (j))
#define XB_XGEN(j)  (2304 + 64 * (j))
#define XB_TOP      3328
#define XB_TOPGEN   3392
#define XCD_BAR_WORDS 3456
#define XB_SPIN_CAP (1u << 24)

__device__ __forceinline__ unsigned xb_ld(unsigned* p)              { return __hip_atomic_load(p, __ATOMIC_RELAXED, __HIP_MEMORY_SCOPE_AGENT); }
__device__ __forceinline__ unsigned xb_add(unsigned* p, unsigned v) { return __hip_atomic_fetch_add(p, v, __ATOMIC_RELAXED, __HIP_MEMORY_SCOPE_AGENT); }
__device__ __forceinline__ unsigned xb_xcc_id() { return (unsigned)__builtin_amdgcn_s_getreg((3 << 11) | 20) & 0xFu; }
#define XB_SPIN(cond, bar) do { unsigned _sp = 0; while (cond) { __builtin_amdgcn_s_sleep(1); \
    if ((++_sp & 255u) == 0u) { if (xb_ld(&(bar)[XB_TMO])) break; if (_sp > XB_SPIN_CAP) { atomicAdd(&(bar)[XB_TMO], 1u); break; } } } } while (0)

struct XcdBarrier {
    unsigned* bar; unsigned x;
    volatile LAS unsigned* st;
};

__device__ __forceinline__ XcdBarrier xcd_barrier_post(unsigned* bar, volatile LAS unsigned* st) {
    XcdBarrier b; b.bar = bar; b.x = xb_xcc_id(); b.st = st;
    if (threadIdx.x == 0) (void)xb_add(&bar[XB_XCNT(b.x)], 1u);
    return b;
}
__device__ __forceinline__ void xcd_barrier_complete(unsigned* bar, unsigned x, unsigned& nloc, unsigned& nx) {
    const unsigned G = gridDim.x * gridDim.y * gridDim.z;
    unsigned sum, cnt, mine, sp = 0u;
    for (;;) {
        sum = 0u; cnt = 0u; mine = 0u;
#pragma unroll
        for (unsigned j = 0; j < 16; ++j) { const unsigned c = xb_ld(&bar[XB_XCNT(j)]); sum += c; cnt += (c > 0u) ? 1u : 0u; mine = (j == x) ? c : mine; }
        if (sum == G) break;
        __builtin_amdgcn_s_sleep(1);
        if ((++sp & 255u) == 0u) { if (xb_ld(&bar[XB_TMO])) break; if (sp > XB_SPIN_CAP) { atomicAdd(&bar[XB_TMO], 1u); break; } }
    }
    nloc = mine > 0u ? mine : 1u; nx = cnt > 0u ? cnt : 1u;
}

__device__ __forceinline__ void xcd_barrier(const XcdBarrier& b) {
    asm volatile("s_waitcnt vmcnt(0)" ::: "memory");
    __syncthreads();
    if (threadIdx.x == 0) {
        unsigned* bar = b.bar;
        __builtin_amdgcn_s_waitcnt(0);
        unsigned nloc = b.st[0], nx = b.st[1];
        if (nloc == 0u) { xcd_barrier_complete(bar, b.x, nloc, nx); b.st[0] = nloc; b.st[1] = nx; }
        const unsigned old = xb_add(&bar[XB_XSUB(b.x)], 1u);
        const unsigned gen = old / nloc;
        if (old + 1u == (gen + 1u) * nloc) {
            __builtin_amdgcn_fence(__ATOMIC_RELEASE, "agent");
            asm volatile("s_waitcnt vmcnt(0)" ::: "memory");
            const unsigned og = xb_add(&bar[XB_TOP], 1u);
            const unsigned tg = og / nx;
            if (og + 1u == (tg + 1u) * nx) xb_add(&bar[XB_TOPGEN], 1u);
            else XB_SPIN(xb_ld(&bar[XB_TOPGEN]) == tg, bar);
            __builtin_amdgcn_fence(__ATOMIC_ACQUIRE, "agent");
            asm volatile("s_waitcnt vmcnt(0)" ::: "memory");
        } else {
            XB_SPIN(xb_ld(&bar[XB_TOPGEN]) == gen, bar);
            __builtin_amdgcn_fence(__ATOMIC_ACQUIRE, "agent");
            asm volatile("s_waitcnt vmcnt(0)" ::: "memory");
        }
    }
    __syncthreads();
}

struct Params { const float* in[24]; float* out; unsigned char* ws; };
enum { K_NONE = 0, K_BF16, K_SWIGLU, K_RESID, K_SOFTMAX, K_PREP, K_NORM, K_POOL, K_GLA1, K_SCAN, K_GLA3, K_KMVT, K_XPRE };

__global__ void __launch_bounds__(512) fwd_megakernel(Params p) {
    extern __shared__ __attribute__((aligned(16))) unsigned char lds_raw[];
    cg::grid_group grid = cg::this_grid();
    LAS unsigned char* L = (LAS unsigned char*)lds_raw;
    const int G = gridDim.x, blk = blockIdx.x;
    const int ngw = G * 8, nthreads = G * 512;
    unsigned char* const ws0 = p.ws;
#define WSB(off) ((bf16_t*)(ws + (off)))
#define WSF(off) ((float*)(ws + (off)))
    if (threadIdx.x < 2) ((volatile LAS unsigned*)(L + BARST_OFF))[threadIdx.x] = 0u;
    __syncthreads();
    const XcdBarrier bar = xcd_barrier_post((unsigned*)ws0, (volatile LAS unsigned*)(L + BARST_OFF));
    grid.sync();

#ifdef REP_K
#ifdef REP_K2
    constexpr int NK = 21;
#else
    constexpr int NK = 20;
#endif
#else
    constexpr int NK = 19;
#endif
#pragma unroll 1
    for (int op = 0; op < 4 * NK + 1; ++op) {
        const __attribute__((address_space(4))) unsigned long long* KA = (const __attribute__((address_space(4))) unsigned long long*)__builtin_amdgcn_kernarg_segment_ptr(); asm volatile("" : "+s"(KA));
#define PIN(i) ((const float*)KA[i])
        unsigned char* ws = (unsigned char*)KA[25]; float* const X = (float*)KA[24];
        bf16_t* const MQ = (bf16_t*)((unsigned char*)X + 64 * MiB); bf16_t* const NVT = (bf16_t*)((unsigned char*)X + 80 * MiB);
        int tid = threadIdx.x; asm volatile("" : "+v"(tid));
        const int lane = tid & 63, wave = __builtin_amdgcn_readfirstlane(tid >> 6), gw = blk * 8 + wave, gtid = blk * 512 + tid;
#ifdef DBG_STOP
        if (op > DBG_STOP && op < 4 * NK) continue;
#endif
        const int layer = op / NK; int k = op - layer * NK;
        const bool extra = (k >= 19);
#ifdef REP_K2
        if (k == 20) k = REP_K2; else
#endif
#ifdef REP_K
        if (k == 19) k = REP_K;
#endif
        const int jm = layer >> 1; const bool is_gla = (layer & 1) == 0;
        int kind = K_NONE; bool sync = true; int order_c = blk;
        pg8::Gemm g = pg8::mk_gemm(nullptr, DM, nullptr, DM, T, DM, DM);
        bf16_t* eO = nullptr; int eldc = DM; float escale = 1.0f; const float* essq = nullptr; float* et16 = nullptr;
        bf16_t* rout = extra ? WSB(WS_KVS) : WSB(WS_XN); float ralpha = 1.0f; const float* rbias = nullptr; const float* rscale = nullptr;
        const float* nsrc = X; const float* ngain = nullptr; int nmode = 0; float* nfout = nullptr;
#ifdef DBG_DIGEST
        if (layer == 4) {
            const float* t16 = WSF(WS_T16); const bf16_t* proj = WSB(WS_PROJ); const float* bb = WSF(WS_XN); const float* dec = WSF(WS_DEC); const bf16_t* kvs = WSB(WS_KVS);
            for (size_t i = gtid; i < (size_t)T * DM; i += nthreads) {
                const size_t r = i >> 10, c = i & 1023; float code = 0.f;
#define BADF(v) (!(fabsf(v) < 1e6f))
                if ((DBG_MASK & 64) && BADF(t16[i % ((size_t)T * 16)])) code += 64.f;
                if ((DBG_MASK & 32) && (BADF(bf2f(proj[r * NPROJ + c])) || BADF(bf2f(proj[r * NPROJ + 2048 + c])))) code += 32.f;
                if ((DBG_MASK & 16) && BADF(bb[i % ((size_t)T * 512)])) code += 16.f;
                if ((DBG_MASK & 8) && BADF(dec[i % ((size_t)2048 * 128)])) code += 8.f;
                if ((DBG_MASK & 4) && (BADF(bf2f(kvs[i])) || BADF(bf2f(kvs[i + (size_t)T * DM])))) code += 4.f;
                if ((DBG_MASK & 1) && BADF(bf2f(proj[r * NPROJ + 1024 + c]))) code += 1.f;
                X[i] = code * 1000.f + bf2f(kvs[i]) + bf2f(kvs[i + (size_t)T * DM]);
            }
            break;
        }
#endif
        if (layer == 4) { kind = K_NORM; sync = false; }
        else switch (k) {
            case 0: kind = K_PREP; break;
            case 1: kind = K_SWIGLU; g = pg8::mk_gemm(WSB(WS_XN), DM, WSB(WS_WGU1), DM, T, NGU, DM); eO = WSB(WS_ACT); sync = false; break;
            case 2: if (layer == 0) kind = K_KMVT; else sync = false; break;
            case 3: kind = K_XPRE; break;
            case 4: kind = K_RESID; g = pg8::mk_gemm(WSB(WS_ACT), FF, WSB(WS_WD1), FF, T, DM, FF); ralpha = 0.5f; break;
            case 5: sync = false; break;
            case 6: if (is_gla) { kind = K_BF16; g = pg8::mk_gemm(WSB(WS_XN), DM, WSB(WS_WIN), DM, T, NPROJP, DM); eO = WSB(WS_PROJ); eldc = NPROJ; essq = WSF(WS_SSQP); et16 = WSF(WS_T16); } else kind = K_POOL; break;
            case 7: if (is_gla) kind = K_GLA1; else { kind = K_RESID; g = pg8::mk_gemm(WSB(WS_PG), 256, WSB(WS_WPOOL), 256, T, DM, 256); g.a_pn = (long)T * 256 * 2; rbias = PIN(13) + jm * DM; rscale = PIN(14) + jm * DM; } break;
            case 8: if (is_gla) kind = K_SCAN; else sync = false; break;
            case 9: if (is_gla) kind = K_GLA3; else sync = false; break;
            case 10: if (is_gla) { kind = K_RESID; g = pg8::mk_gemm(WSB(WS_PROJ) + 1024, NPROJ, WSB(WS_WOUT), DM, T, DM, DM); } else sync = false; break;
            case 11: sync = false; break;
            case 12: sync = false; break;
            case 13: kind = K_SOFTMAX; g = pg8::mk_gemm(WSB(WS_XN), DM, MQ, DM, T, DM, DM); g.b_pb = (long)DM * DM * 2; eO = WSB(WS_P); break;
            case 14: sync = false; break;
            case 15: kind = K_RESID; g = pg8::mk_gemm(WSB(WS_P), DM, NVT, DM, T, DM, DM); g.b_pb = (long)DM * DM * 2; break;
            case 16: sync = false; break;
            case 17: kind = K_SWIGLU; g = pg8::mk_gemm(WSB(WS_XN), DM, WSB(WS_WGU2), DM, T, NGU, DM); eO = WSB(WS_ACT); break;
            default: kind = K_RESID; g = pg8::mk_gemm(WSB(WS_ACT), FF, WSB(WS_WD2), FF, T, DM, FF); ralpha = 0.5f; break;
        }
        if (extra) sync = true;
        switch (kind) {
            case K_BF16: case K_KMVT: case K_XPRE: {
                const int nj = kind == K_KMVT ? 8 : (kind == K_XPRE ? 2 : 1);
#pragma unroll 1
                for (int j = 0; j < nj; ++j) {
                    if (kind == K_KMVT) { const int l = j >> 1; const bf16_t* wkv = WSB(WS_WKV4) + (size_t)l * 2048 * DM; order_c = (blk + 32 * j) % G;
                        g = pg8::mk_gemm(WSB(WS_MEMN), DM, wkv + (size_t)(j & 1) * DM * DM, DM, 2048, DM, DM); eO = ((j & 1) ? WSB(WS_VT4) : WSB(WS_KM4)) + (size_t)l * 2048 * DM; eldc = DM; }
                    if (kind == K_XPRE) { order_c = (blk + 128 * j) % G;
                        if (j == 0) { g = pg8::mk_gemm(WSB(WS_KM4) + (size_t)layer * 2048 * DM, DM, WSB(WS_WQ), DM, 8192, DM, 256); g.mode = 1; eO = MQ; }
                        else { g = pg8::mk_gemm(WSB(WS_WO), DM, WSB(WS_VT4) + (size_t)layer * 2048 * DM, DM, 8192, DM, 256); g.mode = 2; eO = NVT; }
                        eldc = DM; }
                    pg8::StaticOrder S; S.init(g.M, g.N, G, order_c); pg8::EpiBf16 E{eO, eldc, escale, essq, et16, (LAS float*)(L + SMX_OFF + 8192 + 256)}; pg8::gemm_phase(L, g, S, E, tid);
                } } break;
            case K_SWIGLU: { pg8::StaticOrder S; S.init(g.M, g.N, G, order_c); pg8::EpiSwiglu E{eO, WSF(WS_SSQP), (LAS float*)(L + SMX_OFF + 8192 + 256)}; pg8::gemm_phase(L, g, S, E, tid); } break;
            case K_RESID: { pg8::StaticOrder S; S.init(g.M, g.N, G, order_c); pg8::EpiResid E{WSB(WS_XN), rout, ralpha, rbias, rscale, extra ? nullptr : WSF(WS_SSQP)}; pg8::gemm_phase(L, g, S, E, tid); } break;
            case K_SOFTMAX: { pg8::StaticOrder S; S.init(g.M, g.N, G, order_c); pg8::EpiSoftmax E{eO, L + SMX_OFF, WSF(WS_SSQP), 0.0625f}; pg8::gemm_phase(L, g, S, E, tid); } break;
            case K_PREP: {
                LAS float* scr = (LAS float*)(L + wave * 16384);
                const int nkv = layer == 0 ? 4 * (16 * 64) : 0;
                const int total = 2 * (16 * 176) + 2 * (44 * 32) + 2048 + nkv + 16 * 32 + (is_gla ? (16 * 96 + 16 * 32 + 16 + 480) : 4 * (4 * 8));
#pragma unroll 1
                for (int it0 = gw; it0 < total; it0 += ngw) {
                    int it = it0;
                    if (prep_gu(it, PIN(3) + (size_t)layer * DM * NGU, WSB(WS_WGU1), scr, lane, PIN(2) + layer * DM)) continue;
                    if (prep_gu(it, PIN(21) + (size_t)layer * DM * NGU, WSB(WS_WGU2), scr, lane, PIN(20) + layer * DM)) continue;
                    const float* W; bf16_t* WT; int Kd, Nd; const float* gn = nullptr;
                    if (it < 44 * 32) { W = PIN(4) + (size_t)layer * FF * DM; WT = WSB(WS_WD1); Kd = FF; Nd = DM; }
                    else if ((it -= 44 * 32) < 44 * 32) { W = PIN(22) + (size_t)layer * FF * DM; WT = WSB(WS_WD2); Kd = FF; Nd = DM; }
                    else if ((it -= 44 * 32) < 2048) { convert_item(PIN(17) + (size_t)layer * DM * DM, WSB(WS_WQ), PIN(15) + layer * DM, it, lane); continue; }
                    else if ((it -= 2048) < nkv) { const int l = it >> 10; it &= 1023; W = PIN(18) + (size_t)l * DM * 2048; WT = WSB(WS_WKV4) + (size_t)l * 2048 * DM; Kd = DM; Nd = 2048; gn = PIN(16) + l * DM; }
                    else if ((it -= nkv) < 16 * 32) { W = PIN(19) + (size_t)layer * DM * DM; WT = WSB(WS_WO); Kd = DM; Nd = DM; }
                    else { it -= 16 * 32;
                        if (is_gla) {
                            if (it < 16 * 96) { W = PIN(6) + (size_t)jm * DM * NPROJ; WT = WSB(WS_WIN); Kd = DM; Nd = NPROJ; gn = PIN(5) + layer * DM; }
                            else if ((it -= 16 * 96) < 16 * 32) { W = PIN(11) + (size_t)jm * DM * DM; WT = WSB(WS_WOUT); Kd = DM; Nd = DM; }
                            else if ((it -= 16 * 32) < 16) {
                                const int r = lane & 15, kq = lane >> 4, kb = it * 64 + kq * 16; const float* wg1 = PIN(7) + (size_t)jm * DM * 16; const float* gm = PIN(5) + layer * DM;
                                bf16_t* d = WSB(WS_WIN) + (size_t)(NPROJ + r) * DM + kb;
#pragma unroll
                                for (int i = 0; i < 16; i += 2) *(unsigned*)(d + i) = cvt_pk_bf16(gm[kb + i] * wg1[(size_t)(kb + i) * 16 + r], gm[kb + i + 1] * wg1[(size_t)(kb + i + 1) * 16 + r]);
                                continue; }
                            else { it -= 16;
                                unsigned zz = 0u; asm volatile("" : "+v"(zz));
                                *(u32x4*)((unsigned char*)(WSB(WS_WIN) + (size_t)(NPROJ + 16) * DM) + (size_t)it * 1024 + lane * 16) = (u32x4){zz, zz, zz, zz}; continue; }
                        }
                        else { const int gq = it >> 5; it &= 31; W = PIN(12) + (size_t)(jm * 4 + gq) * 65536; WT = WSB(WS_WPOOL) + gq * 65536; Kd = 256; Nd = 256; } }
                    prep_plain(it, W, Kd, Nd, WT, scr, lane, gn);
                }
                if (layer == 0) norm_phase(PIN(1), nullptr, WSB(WS_MEMN), nullptr, nullptr, nullptr, 0, 2048, gw, ngw, lane);
                if (layer == 0) norm_phase(PIN(0), nullptr, WSB(WS_XN), nullptr, nullptr, WSF(WS_SSQP), 3, T, gw, ngw, lane);
            } break;
            case K_NORM: final_norm(WSB(WS_XN), PIN(23), X, gw, ngw, lane); break;
            case K_POOL: pool_phase(L, WSB(WS_XN), WSF(WS_SSQP), PIN(5) + layer * DM, WSB(WS_PG), blk, G, tid); break;
            case K_GLA1: gla_pass1(L, WSB(WS_PROJ), WSF(WS_T16), PIN(8) + (size_t)jm * 16 * 512, PIN(9) + jm * 512, extra ? WSF(WS_P) : X, WSB(WS_KVS), WSF(WS_DEC), blk, G, tid); break;
            case K_SCAN: gla_scan(WSB(WS_KVS), WSF(WS_DEC), gtid, nthreads); break;
            case K_GLA3: gla_pass3(L, WSB(WS_PROJ), X, WSB(WS_KVS), PIN(10) + jm * 256, blk, G, tid); break;
            default: break;
        }
        if (sync) xcd_barrier(bar);
    }
}

extern "C" void kernel_launch(void* const* d_in, const int* in_sizes, int n_in, void* d_out, int out_size, void* d_ws, size_t ws_size, hipStream_t stream) {
    static int grid_blocks = 0;
    if (grid_blocks == 0) {
        if (n_in != 24 || out_size != T * DM || ws_size < WS_END) { fprintf(stderr, "kernel_launch: unexpected sizes (n_in %d out %d ws %zu)\n", n_in, out_size, ws_size); grid_blocks = -1; return; }
        int dev = 0, cus = 0, per_cu = 0;
        hipGetDevice(&dev);
        hipDeviceGetAttribute(&cus, hipDeviceAttributeMultiprocessorCount, dev);
        hipFuncSetAttribute((const void*)fwd_megakernel, hipFuncAttributeMaxDynamicSharedMemorySize, LDS_BYTES);
        hipOccupancyMaxActiveBlocksPerMultiprocessor(&per_cu, (const void*)fwd_megakernel, 512, LDS_BYTES);
        if (per_cu < 1) { fprintf(stderr, "kernel_launch: occupancy query says %d blocks per CU\n", per_cu); per_cu = 1; }
        (void)hipGetLastError();
        grid_blocks = cus & ~3;
    }
    if (grid_blocks < 0) return;
    if (hipMemsetAsync(d_ws, 0, 65536, stream) != hipSuccess) { fprintf(stderr, "kernel_launch: memset failed\n"); return; }
    Params p{};
    for (int i = 0; i < 24; ++i) p.in[i] = (const float*)d_in[i];
    p.out = (float*)d_out; p.ws = (unsigned char*)d_ws;
    void* args[] = {&p};
    hipError_t e = hipLaunchCooperativeKernel((const void*)fwd_megakernel, dim3(grid_blocks), dim3(512), args, LDS_BYTES, stream);
    if (e != hipSuccess) fprintf(stderr, "cooperative launch failed: %s (grid %d)\n", hipGetErrorString(e), grid_blocks);
}
```

```cpp
#include <hip/hip_runtime.h>
#include <hip/hip_cooperative_groups.h>
#include <cstdint>
#include <cstdio>
namespace cg = cooperative_groups;

#define LAS __attribute__((address_space(3)))
typedef unsigned short bf16_t;
typedef short bf16x8 __attribute__((ext_vector_type(8)));
typedef float f32x4 __attribute__((ext_vector_type(4)));
typedef unsigned u32x4 __attribute__((ext_vector_type(4)));
typedef unsigned u32x2 __attribute__((ext_vector_type(2)));

constexpr int T = 32768, DM = 1024, FF = 2816, NGU = 5632, SEQ = 4096, NPROJ = 3072, NPROJP = 3328;
constexpr float EPS = 1e-6f;
constexpr size_t MiB = 1u << 20;
constexpr size_t WS_WGU1 = 1 * MiB, WS_WGU2 = 12 * MiB, WS_WD1 = 23 * MiB, WS_WD2 = 29 * MiB, WS_WIN = 35 * MiB, WS_WOUT = 41 * MiB + MiB / 2,
                 WS_WPOOL = 43 * MiB, WS_WQ = 44 * MiB, WS_WKV = 46 * MiB, WS_WO = 50 * MiB, WS_MEMN = 52 * MiB, WS_KM = 56 * MiB, WS_VT = 60 * MiB,
                 WS_T16 = 64 * MiB, WS_DEC = 66 * MiB, WS_XN = 68 * MiB, WS_BIG = 132 * MiB, WS_SSQP = 452 * MiB, WS_WKV4 = 454 * MiB, WS_KM4 = 470 * MiB, WS_VT4 = 486 * MiB, WS_END = 502 * MiB;
constexpr size_t WS_ACT = WS_BIG, WS_PROJ = WS_BIG, WS_KVS = WS_BIG + 192 * MiB, WS_Q = WS_BIG, WS_P = WS_BIG + 64 * MiB, WS_O = WS_BIG + 128 * MiB,
                 WS_HF = WS_BIG, WS_PG = WS_BIG + 128 * MiB;
constexpr int LDS_BYTES = 147456;
constexpr int SMX_OFF = 131072, BARST_OFF = 131072 + 8192;

typedef float f32x2 __attribute__((ext_vector_type(2)));
typedef __bf16 bf16x2_t __attribute__((ext_vector_type(2)));
__device__ __forceinline__ unsigned cvt_pk_bf16(float lo, float hi) { const f32x2 v = {lo, hi}; const bf16x2_t b = __builtin_convertvector(v, bf16x2_t); return __builtin_bit_cast(unsigned, b); }
__device__ __forceinline__ float bf2f(unsigned v) { return __uint_as_float(v << 16); }
__device__ __forceinline__ float bflo(unsigned v) { return __uint_as_float(v << 16); }
__device__ __forceinline__ float bfhi(unsigned v) { return __uint_as_float(v & 0xffff0000u); }
__device__ __forceinline__ float silu_f(float g) { return g * __builtin_amdgcn_rcpf(1.f + __expf(-g)); }
__device__ __forceinline__ float shx(float v, int mask, int lane) { return __builtin_bit_cast(float, __builtin_amdgcn_ds_bpermute((lane ^ mask) << 2, __builtin_bit_cast(int, v))); }
__device__ __forceinline__ float shl_(float v, int src, int lane) { (void)lane; return __builtin_bit_cast(float, __builtin_amdgcn_ds_bpermute(src << 2, __builtin_bit_cast(int, v))); }
__device__ __forceinline__ float wave_sum(float v, int lane) {
#pragma unroll
    for (int o = 1; o < 64; o <<= 1) v += shx(v, o, lane);
    return v;
}

namespace pg8 {
constexpr int BM = 256, BK = 64, HALF = 128, HTB = HALF * BK * 2, STAGE_BYTES = 8 * HTB, NXCD = 8, WGM = 8;
__host__ __device__ __forceinline__ int lds_byte(int r, int c) { const int st = (r >> 4) * 2 + (c >> 5), rr = r & 15, cc = c & 31, ob = rr * 64 + cc * 2; return st * 1024 + (ob ^ (((ob >> 9) & 1) << 5)); }
__host__ __device__ __forceinline__ void stage_rc(int b, int& R, int& C) { const int st = b / 1024, sb = b % 1024, swz = sb ^ (((sb >> 9) & 1) << 5); R = (st >> 1) * 16 + swz / 64; C = (st & 1) * 32 + (swz % 64) / 2; }
__host__ __device__ __forceinline__ int perm32(int rho) { const int n = rho >> 4, i = rho & 15; return 8 * (i >> 2) + 4 * n + (i & 3); }

struct Unit { int pm, pn; };
struct Gemm { const bf16_t* A; const bf16_t* Bt; int M, N, K, lda, ldb; long a_pm, a_pn, b_pb, b_pn; int mode; };
__device__ __forceinline__ Gemm mk_gemm(const bf16_t* A, int lda, const bf16_t* Bt, int ldb, int M, int N, int K) {
    Gemm g; g.A = A; g.Bt = Bt; g.M = M; g.N = N; g.K = K; g.lda = lda; g.ldb = ldb; g.a_pm = (long)BM * lda * 2; g.a_pn = 0; g.b_pb = 0; g.b_pn = (long)BM * ldb * 2; g.mode = 0; return g;
}

__device__ __forceinline__ const char* unit_a(const Gemm& g, const Unit& u) {
    if (g.mode == 1) return (const char*)g.A + (size_t)(u.pm >> 2) * (256 * 1024 * 2) + (size_t)(u.pm & 3) * 512;
    if (g.mode == 2) return (const char*)g.A + (size_t)(u.pm & 3) * (256 * 1024 * 2) + (size_t)u.pn * 512;
    return (const char*)g.A + (size_t)u.pm * g.a_pm + (size_t)u.pn * g.a_pn;
}
__device__ __forceinline__ const char* unit_b(const Gemm& g, const Unit& u) {
    if (g.mode == 1) return (const char*)g.Bt + (size_t)u.pn * (256 * 1024 * 2) + (size_t)(u.pm & 3) * 512;
    if (g.mode == 2) return (const char*)g.Bt + (size_t)(u.pm >> 2) * (256 * 1024 * 2) + (size_t)u.pn * 512;
    return (const char*)g.Bt + (size_t)(u.pm >> 4) * g.b_pb + (size_t)u.pn * g.b_pn;
}
struct StaticOrder {
    int nM, nN, nwg, G, c;
    __device__ void init(int M, int N, int G_, int c_) { nM = M / BM; nN = N / BM; nwg = nM * nN; G = G_; c = c_; }
    __device__ bool next(int i, Unit& u) const {
        const long L = (long)i * G + c; if (L >= nwg) return false;
        int wgid = (int)L; { const int q = nwg / NXCD, r = nwg % NXCD, xcd = wgid % NXCD, off = wgid / NXCD; wgid = (xcd < r ? xcd * (q + 1) : r * (q + 1) + (xcd - r) * q) + off; }
        const int nig = WGM * nN, gid = wgid / nig, fm = gid * WGM, gsz = (nM - fm) < WGM ? (nM - fm) : WGM;
        u.pm = fm + ((wgid % nig) % gsz); u.pn = (wgid % nig) / gsz; return true;
    }
};

__device__ __forceinline__ float row_rs(const float* ssqp, int row) {
    const f32x4* q = (const f32x4*)(ssqp + (size_t)row * 16); const f32x4 a = q[0], b = q[1], c = q[2], d = q[3];
    const float s = ((a[0] + a[1]) + (a[2] + a[3])) + ((b[0] + b[1]) + (b[2] + b[3])) + ((c[0] + c[1]) + (c[2] + c[3])) + ((d[0] + d[1]) + (d[2] + d[3]));
    return 1.0f / sqrtf(s * (1.0f / DM) + EPS);
}
__device__ __forceinline__ void fill_rsc(LAS float* RSC, const float* ssqp, float scale, const Unit& u, int wr, int wc, int fr, int fq) {
    const int t_ = (wr * 4 + wc) * 64 + fq * 16 + fr;
    if (t_ < 256) RSC[t_] = scale * row_rs(ssqp, u.pm * BM + t_);
    asm volatile("s_waitcnt lgkmcnt(0)" ::: "memory"); __builtin_amdgcn_s_barrier(); asm volatile("" ::: "memory");
}
struct EpiBf16 {
    bf16_t* O; int ldc; float scale; const float* ssqp; float* t16; LAS float* RSC;
    __device__ __forceinline__ void operator()(f32x4 (&acc)[2][2][4][2], const Unit& u, int wr, int wc, int fr, int fq) const {
        const int row0 = u.pm * BM + wr * 64 + fr, col0 = u.pn * BM + wc * 32 + 8 * fq;
        const bool gate_tile = (t16 != nullptr) && (u.pn == 12);
        if (ssqp) fill_rsc(RSC, ssqp, scale, u, wr, wc, fr, fq);
#pragma unroll
        for (int ai = 0; ai < 2; ++ai)
#pragma unroll
            for (int m = 0; m < 4; ++m) { const int row = row0 + ai * HALF + m * 16; bf16_t* rowp = O + (size_t)row * ldc + col0;
                const float sc = ssqp ? RSC[ai * HALF + wr * 64 + m * 16 + fr] : scale;
                if (gate_tile) { if (wc == 0 && fq < 2) { *(f32x4*)(t16 + (size_t)row * 16 + 8 * fq) = acc[ai][0][m][0] * sc; *(f32x4*)(t16 + (size_t)row * 16 + 8 * fq + 4) = acc[ai][0][m][1] * sc; } continue; }
#pragma unroll
                for (int bj = 0; bj < 2; ++bj) { const f32x4 v0 = acc[ai][bj][m][0] * sc, v1 = acc[ai][bj][m][1] * sc; u32x4 w;
                    w.x = cvt_pk_bf16(v0[0], v0[1]); w.y = cvt_pk_bf16(v0[2], v0[3]); w.z = cvt_pk_bf16(v1[0], v1[1]); w.w = cvt_pk_bf16(v1[2], v1[3]);
                    *(u32x4*)(rowp + bj * HALF) = w; } }
    }
};
struct EpiSwiglu {
    bf16_t* O; const float* ssqp; LAS float* RSC;
    __device__ __forceinline__ void operator()(f32x4 (&acc)[2][2][4][2], const Unit& u, int wr, int wc, int fr, int fq) const {
        const int row0 = u.pm * BM + wr * 64 + fr, col0 = u.pn * HALF + wc * 32 + 8 * fq;
        fill_rsc(RSC, ssqp, 1.0f, u, wr, wc, fr, fq);
#pragma unroll
        for (int ai = 0; ai < 2; ++ai)
#pragma unroll
            for (int m = 0; m < 4; ++m) { const int row = row0 + ai * HALF + m * 16; bf16_t* rowp = O + (size_t)row * FF + col0;
                const float rs = RSC[ai * HALF + wr * 64 + m * 16 + fr];
                const f32x4 g0 = acc[ai][0][m][0] * rs, g1 = acc[ai][0][m][1] * rs, u0 = acc[ai][1][m][0] * rs, u1 = acc[ai][1][m][1] * rs; u32x4 w;
                w.x = cvt_pk_bf16(silu_f(g0[0]) * u0[0], silu_f(g0[1]) * u0[1]); w.y = cvt_pk_bf16(silu_f(g0[2]) * u0[2], silu_f(g0[3]) * u0[3]);
                w.z = cvt_pk_bf16(silu_f(g1[0]) * u1[0], silu_f(g1[1]) * u1[1]); w.w = cvt_pk_bf16(silu_f(g1[2]) * u1[2], silu_f(g1[3]) * u1[3]);
                *(u32x4*)rowp = w; }
    }
};
struct EpiResid {
    const bf16_t* base; bf16_t* out; float alpha; const float* bias; const float* cscale; float* ssqp;
    template <bool HAS_BIAS>
    __device__ __forceinline__ void quarter(f32x4 (&acc)[2][2][4][2], const Unit& u, const int ai, const int mp, int wr, int wc, int fr, int fq) const {
        const int row0 = u.pm * BM + wr * 64 + fr + ai * HALF, col0 = u.pn * BM + wc * 32 + 8 * fq;
        u32x4 bw[2][2];
#pragma unroll
        for (int mm = 0; mm < 2; ++mm)
#pragma unroll
            for (int bj = 0; bj < 2; ++bj) bw[mm][bj] = *(const u32x4*)(base + (unsigned)((row0 + (2 * mp + mm) * 16) * DM + col0 + bj * HALF));
        asm volatile("" ::: "memory");
#pragma unroll
        for (int mm = 0; mm < 2; ++mm) { const int m = 2 * mp + mm, row = row0 + m * 16; const unsigned off = (unsigned)(row * DM + col0); float ss = 0.f;
#pragma unroll
            for (int bj = 0; bj < 2; ++bj) {
                f32x4 d0 = acc[ai][bj][m][0], d1 = acc[ai][bj][m][1];
                if (HAS_BIAS) { const f32x4 b0 = *(const f32x4*)(bias + col0 + bj * HALF), b1 = *(const f32x4*)(bias + col0 + bj * HALF + 4), s0 = *(const f32x4*)(cscale + col0 + bj * HALF), s1 = *(const f32x4*)(cscale + col0 + bj * HALF + 4);
                    d0 = (d0 + b0) * s0; d1 = (d1 + b1) * s1; }
                const f32x4 x0 = (f32x4){bflo(bw[mm][bj].x), bfhi(bw[mm][bj].x), bflo(bw[mm][bj].y), bfhi(bw[mm][bj].y)} + d0 * alpha;
                const f32x4 x1 = (f32x4){bflo(bw[mm][bj].z), bfhi(bw[mm][bj].z), bflo(bw[mm][bj].w), bfhi(bw[mm][bj].w)} + d1 * alpha;
                ss += ((x0[0] * x0[0] + x0[1] * x0[1]) + (x0[2] * x0[2] + x0[3] * x0[3])) + ((x1[0] * x1[0] + x1[1] * x1[1]) + (x1[2] * x1[2] + x1[3] * x1[3]));
                u32x4 w; w.x = cvt_pk_bf16(x0[0], x0[1]); w.y = cvt_pk_bf16(x0[2], x0[3]); w.z = cvt_pk_bf16(x1[0], x1[1]); w.w = cvt_pk_bf16(x1[2], x1[3]);
                *(u32x4*)(out + off + bj * HALF) = w; }
            ss += shx(ss, 16, fq * 16 + fr); ss += shx(ss, 32, fq * 16 + fr);
            if (ssqp != nullptr && fq == 0) ssqp[(size_t)row * 16 + 4 * u.pn + wc] = ss; }
    }
    __device__ __forceinline__ void operator()(f32x4 (&acc)[2][2][4][2], const Unit& u, int wr, int wc, int fr, int fq) const {
        if (bias) { quarter<true>(acc, u, 0, 0, wr, wc, fr, fq); quarter<true>(acc, u, 0, 1, wr, wc, fr, fq); quarter<true>(acc, u, 1, 0, wr, wc, fr, fq); quarter<true>(acc, u, 1, 1, wr, wc, fr, fq); }
        else { quarter<false>(acc, u, 0, 0, wr, wc, fr, fq); quarter<false>(acc, u, 0, 1, wr, wc, fr, fq); quarter<false>(acc, u, 1, 0, wr, wc, fr, fq); quarter<false>(acc, u, 1, 1, wr, wc, fr, fq); }
    }
};
struct EpiSoftmax {
    bf16_t* O; LAS unsigned char* tab; const float* ssqp; float scale;
    __device__ __forceinline__ void operator()(f32x4 (&acc)[2][2][4][2], const Unit& u, int wr, int wc, int fr, int fq) const {
        LAS float* MX = (LAS float*)tab; LAS float* SM = (LAS float*)(tab + 4096);
        LAS float* RSC = (LAS float*)(tab + 8192 + 256);
        fill_rsc(RSC, ssqp, scale, u, wr, wc, fr, fq);
#pragma unroll
        for (int ai = 0; ai < 2; ++ai)
#pragma unroll
            for (int m = 0; m < 4; ++m) { const float sc = RSC[ai * HALF + wr * 64 + m * 16 + fr];
#pragma unroll
                for (int bj = 0; bj < 2; ++bj)
#pragma unroll
                    for (int n = 0; n < 2; ++n) acc[ai][bj][m][n] = acc[ai][bj][m][n] * sc; }
#pragma unroll
        for (int ai = 0; ai < 2; ++ai)
#pragma unroll
            for (int m = 0; m < 4; ++m) { float mx = -3.0e38f;
#pragma unroll
                for (int bj = 0; bj < 2; ++bj)
#pragma unroll
                    for (int n = 0; n < 2; ++n) { const f32x4 x = acc[ai][bj][m][n]; mx = fmaxf(mx, fmaxf(fmaxf(x[0], x[1]), fmaxf(x[2], x[3]))); }
                mx = fmaxf(mx, shx(mx, 16, fq * 16 + fr)); mx = fmaxf(mx, shx(mx, 32, fq * 16 + fr));
                if (fq == 0) MX[(ai * HALF + wr * 64 + m * 16 + fr) * 4 + wc] = mx; }
        asm volatile("s_waitcnt lgkmcnt(0)" ::: "memory"); __builtin_amdgcn_s_barrier(); asm volatile("" ::: "memory");
#pragma unroll
        for (int ai = 0; ai < 2; ++ai)
#pragma unroll
            for (int m = 0; m < 4; ++m) { const int r = ai * HALF + wr * 64 + m * 16 + fr; const f32x4 t = *(LAS f32x4*)(MX + r * 4);
                const float mx = fmaxf(fmaxf(t[0], t[1]), fmaxf(t[2], t[3])); float s = 0.f;
#pragma unroll
                for (int bj = 0; bj < 2; ++bj)
#pragma unroll
                    for (int n = 0; n < 2; ++n) { f32x4 x = acc[ai][bj][m][n]; x[0] = __expf(x[0] - mx); x[1] = __expf(x[1] - mx); x[2] = __expf(x[2] - mx); x[3] = __expf(x[3] - mx);
                        acc[ai][bj][m][n] = x; s += (x[0] + x[1]) + (x[2] + x[3]); }
                s += shx(s, 16, fq * 16 + fr); s += shx(s, 32, fq * 16 + fr);
                if (fq == 0) SM[r * 4 + wc] = s; }
        asm volatile("s_waitcnt lgkmcnt(0)" ::: "memory"); __builtin_amdgcn_s_barrier(); asm volatile("" ::: "memory");
        const int row0 = u.pm * BM + wr * 64 + fr, col0 = u.pn * BM + wc * 32 + 8 * fq;
#pragma unroll
        for (int ai = 0; ai < 2; ++ai)
#pragma unroll
            for (int m = 0; m < 4; ++m) { const int r = ai * HALF + wr * 64 + m * 16 + fr; const f32x4 t = *(LAS f32x4*)(SM + r * 4);
                const float inv = 1.0f / ((t[0] + t[1]) + (t[2] + t[3])); bf16_t* rowp = O + (size_t)(row0 + ai * HALF + m * 16) * DM + col0;
#pragma unroll
                for (int bj = 0; bj < 2; ++bj) { const f32x4 v0 = acc[ai][bj][m][0] * inv, v1 = acc[ai][bj][m][1] * inv; u32x4 w;
                    w.x = cvt_pk_bf16(v0[0], v0[1]); w.y = cvt_pk_bf16(v0[2], v0[3]); w.z = cvt_pk_bf16(v1[0], v1[1]); w.w = cvt_pk_bf16(v1[2], v1[3]);
                    *(u32x4*)(rowp + bj * HALF) = w; } }
    }
};

template <class Epi>
__device__ __forceinline__ void gemm_phase(LAS unsigned char* lds, const Gemm g, const StaticOrder& S, const Epi& E, const int tid) {
    const int wid = __builtin_amdgcn_readfirstlane(tid >> 6), lane = tid & 63, wr = wid >> 2, wc = wid & 3, fr = lane & 15, fq = lane >> 4;
    const int K = g.K, nt = K / BK;
    unsigned voffA[2], voffB[2];
#pragma unroll
    for (int i = 0; i < 2; ++i) { int R, C; stage_rc(tid * 16 + i * 8192, R, C); const int Rb = (R & ~31) + perm32(R & 31);
        voffA[i] = (unsigned)(R * g.lda + C) * 2u; voffB[i] = (unsigned)(Rb * g.ldb + C) * 2u; }
    const size_t kstep = (size_t)(BK * 2);
    const size_t hA = (size_t)HALF * g.lda * 2, hB = (size_t)HALF * g.ldb * 2;
    const unsigned ldsw = (unsigned)wid * 1024u;
    const unsigned ldsbase = (unsigned)(size_t)lds;
    const int aoff = lds_byte(wr * 64 + fr, fq * 8), boff = lds_byte(wc * 32 + fr, fq * 8);
#define PG8_SA(b, h) (((b) * 2 + (h)) * HTB)
#define PG8_SB(b, h) ((4 + (b) * 2 + (h)) * HTB)
#define PG8_STAGE(bufoff, gbase, voff) do { const char* _gb = (const char*)(gbase); const unsigned _m0 = ldsbase + (unsigned)(bufoff) + ldsw; \
        asm volatile("s_mov_b32 m0, %0\n\ts_nop 0\n\tglobal_load_lds_dwordx4 %1, %2\n\ts_mov_b32 m0, %4\n\ts_nop 0\n\tglobal_load_lds_dwordx4 %3, %2" \
                     :: "s"(_m0), "v"((voff)[0]), "s"(_gb), "v"((voff)[1]), "s"(_m0 + 8192u) : "memory", "m0"); } while (0)
#define PG8_LDA(dst, b, h) do { _Pragma("unroll") for (int m = 0; m < 4; ++m) _Pragma("unroll") for (int k = 0; k < 2; ++k) dst[m][k] = *(const LAS bf16x8*)(lds + PG8_SA(b, h) + aoff + m * 2048 + k * 1024); } while (0)
#define PG8_LDB(dst, b, h) do { _Pragma("unroll") for (int n = 0; n < 2; ++n) _Pragma("unroll") for (int k = 0; k < 2; ++k) dst[n][k] = *(const LAS bf16x8*)(lds + PG8_SB(b, h) + boff + n * 2048 + k * 1024); } while (0)
#define PG8_MMA(ai, bj, At, Bt) do { __builtin_amdgcn_s_setprio(1); _Pragma("unroll") for (int m = 0; m < 4; ++m) _Pragma("unroll") for (int n = 0; n < 2; ++n) _Pragma("unroll") for (int k = 0; k < 2; ++k) \
        acc[ai][bj][m][n] = __builtin_amdgcn_mfma_f32_16x16x32_bf16(Bt[n][k], At[m][k], acc[ai][bj][m][n], 0, 0, 0); __builtin_amdgcn_s_setprio(0); } while (0)
#define PG8_WAIT_V(n) asm volatile("s_waitcnt vmcnt(" #n ")" ::: "memory")
#define PG8_WAIT_L(n) asm volatile("s_waitcnt lgkmcnt(" #n ")" ::: "memory")
#define PG8_BAR __builtin_amdgcn_s_barrier()
#define PG8_SCHED __builtin_amdgcn_sched_barrier(0)
#define PG8_UA(u) unit_a(g, u)
#define PG8_UB(u) unit_b(g, u)
    Unit cur, nxt; int ui = 0;
    if (!S.next(0, cur)) return;
    f32x4 acc[2][2][4][2];
#pragma unroll
    for (int a = 0; a < 2; ++a)
#pragma unroll
        for (int b = 0; b < 2; ++b)
#pragma unroll
            for (int m = 0; m < 4; ++m)
#pragma unroll
                for (int n = 0; n < 2; ++n) acc[a][b][m][n] = (f32x4){0.f, 0.f, 0.f, 0.f};
    bf16x8 At[4][2], B0[2][2], B1[2][2];
    const char* cA = PG8_UA(cur); const char* cB = PG8_UB(cur);
    PG8_STAGE(PG8_SB(0, 0), cB, voffB); PG8_STAGE(PG8_SB(0, 1), cB + hB, voffB); PG8_STAGE(PG8_SA(0, 0), cA, voffA); PG8_STAGE(PG8_SA(0, 1), cA + hA, voffA);
    if (wr == 1) PG8_BAR;
    PG8_WAIT_V(2); PG8_BAR;
    PG8_STAGE(PG8_SB(1, 0), cB + kstep, voffB); PG8_STAGE(PG8_SA(1, 0), cA + kstep, voffA); PG8_STAGE(PG8_SB(1, 1), cB + hB + kstep, voffB);
    PG8_WAIT_V(6); PG8_BAR;
    for (;;) {
        const bool has_next = S.next(ui + 1, nxt);
        const char* nA = has_next ? PG8_UA(nxt) : cA; const char* nB = has_next ? PG8_UB(nxt) : cB;
        for (int t = 0; t < nt; t += 2) {
            const bool last = (t == nt - 2);
            const char* a1 = cA + (size_t)(t + 1) * kstep;
            const char* a2 = last ? nA : cA + (size_t)(t + 2) * kstep; const char* b2 = last ? nB : cB + (size_t)(t + 2) * kstep;
            const char* a3 = a2 + kstep; const char* b3 = b2 + kstep;
            PG8_LDB(B0, 0, 0); PG8_LDB(B1, 0, 1); PG8_SCHED; PG8_LDA(At, 0, 0); PG8_STAGE(PG8_SA(1, 1), a1 + hA, voffA);
            PG8_WAIT_V(8); PG8_WAIT_L(0); PG8_BAR; PG8_MMA(0, 0, At, B0); PG8_MMA(0, 1, At, B1); PG8_BAR; PG8_SCHED;
            PG8_LDA(At, 0, 1); PG8_STAGE(PG8_SB(0, 0), b2, voffB); PG8_STAGE(PG8_SB(0, 1), b2 + hB, voffB); PG8_STAGE(PG8_SA(0, 0), a2, voffA);
            PG8_WAIT_V(8); PG8_WAIT_L(0); PG8_BAR; PG8_MMA(1, 0, At, B0); PG8_MMA(1, 1, At, B1); PG8_BAR; PG8_SCHED;
            PG8_LDB(B0, 1, 0); PG8_LDB(B1, 1, 1); PG8_SCHED; PG8_LDA(At, 1, 0); PG8_STAGE(PG8_SA(0, 1), a2 + hA, voffA);
            PG8_WAIT_V(8); PG8_WAIT_L(0); PG8_BAR; PG8_MMA(0, 0, At, B0); PG8_MMA(0, 1, At, B1); PG8_BAR; PG8_SCHED;
            PG8_LDA(At, 1, 1); PG8_STAGE(PG8_SB(1, 0), b3, voffB); PG8_STAGE(PG8_SB(1, 1), b3 + hB, voffB); PG8_STAGE(PG8_SA(1, 0), a3, voffA);
            PG8_WAIT_V(8); PG8_WAIT_L(0); PG8_BAR; PG8_MMA(1, 0, At, B0); PG8_MMA(1, 1, At, B1); PG8_BAR; PG8_SCHED;
        }
        if (wr == 0) PG8_BAR;
        E(acc, cur, wr, wc, fr, fq);
        if (!has_next) break;
#pragma unroll
        for (int a = 0; a < 2; ++a)
#pragma unroll
            for (int b = 0; b < 2; ++b)
#pragma unroll
                for (int m = 0; m < 4; ++m)
#pragma unroll
                    for (int n = 0; n < 2; ++n) acc[a][b][m][n] = (f32x4){0.f, 0.f, 0.f, 0.f};
        cur = nxt; cA = nA; cB = nB; ++ui;
        if (wr == 1) PG8_BAR;
    }
    PG8_WAIT_V(0);
    PG8_BAR;
#undef PG8_SA
#undef PG8_SB
#undef PG8_STAGE
#undef PG8_LDA
#undef PG8_LDB
#undef PG8_MMA
#undef PG8_WAIT_V
#undef PG8_WAIT_L
#undef PG8_BAR
#undef PG8_SCHED
#undef PG8_UA
#undef PG8_UB
}
}

__device__ __forceinline__ void norm_phase(const float* xin, const float* gain, bf16_t* xn, float* fout, const float* wg1, float* t16, const int MODE, int nrows, int gw, int ngw, int lane) {
#pragma unroll 4
    for (int row = gw; row < nrows; row += ngw) {
        const f32x4* xr = (const f32x4*)(xin + (size_t)row * DM) + lane;
        f32x4 v[4]; float s = 0.f;
#pragma unroll
        for (int j = 0; j < 4; ++j) { v[j] = xr[64 * j]; s += (v[j][0] * v[j][0] + v[j][1] * v[j][1]) + (v[j][2] * v[j][2] + v[j][3] * v[j][3]); }
        s = wave_sum(s, lane);
        if (MODE == 3) { if (lane < 16) t16[(size_t)row * 16 + lane] = lane == 0 ? s : 0.f; }
        else {
        const float rs = 1.0f / sqrtf(s * (1.0f / DM) + EPS);
#pragma unroll
        for (int j = 0; j < 4; ++j) { const f32x4 gg = gain ? ((const f32x4*)gain)[lane + 64 * j] : (f32x4){1.f, 1.f, 1.f, 1.f}; v[j] = v[j] * rs * gg; }
        }
        if (MODE == 2) {
            f32x4* o = (f32x4*)(fout + (size_t)row * DM) + lane;
#ifdef DBG_STOP
#pragma unroll
            for (int j = 0; j < 4; ++j)
#pragma unroll
                for (int e = 0; e < 4; ++e) if (!(fabsf(v[j][e]) < 1e30f)) v[j][e] = 1e6f;
#endif
#pragma unroll
            for (int j = 0; j < 4; ++j) o[64 * j] = v[j];
        } else {
            u32x2* o = (u32x2*)(xn + (size_t)row * DM) + lane;
#pragma unroll
            for (int j = 0; j < 4; ++j) { u32x2 w; w.x = cvt_pk_bf16(v[j][0], v[j][1]); w.y = cvt_pk_bf16(v[j][2], v[j][3]); o[64 * j] = w; }
        }
        if (MODE == 1) {
            f32x4 a[4];
#pragma unroll
            for (int q = 0; q < 4; ++q) a[q] = (f32x4){0.f, 0.f, 0.f, 0.f};
#pragma unroll
            for (int j = 0; j < 4; ++j)
#pragma unroll
                for (int e = 0; e < 4; ++e) { const f32x4* wp = (const f32x4*)(wg1 + (size_t)(4 * (lane + 64 * j) + e) * 16); const float hv = v[j][e];
#pragma unroll
                    for (int q = 0; q < 4; ++q) a[q] += wp[q] * hv; }
            float outv = 0.f;
#pragma unroll
            for (int q = 0; q < 4; ++q)
#pragma unroll
                for (int e = 0; e < 4; ++e) { const float sres = wave_sum(a[q][e], lane); if (lane == q * 4 + e) outv = sres; }
            if (lane < 16) t16[(size_t)row * 16 + lane] = outv;
        }
    }
}

__device__ __forceinline__ void final_norm(const bf16_t* xb, const float* gain, float* out, int gw, int ngw, int lane) {
#pragma unroll 4
    for (int row = gw; row < T; row += ngw) {
        const u32x4* xr = (const u32x4*)(xb + (size_t)row * DM) + 2 * lane;
        const u32x4 a = xr[0], b = xr[1];
        float v[16] = {bflo(a.x), bfhi(a.x), bflo(a.y), bfhi(a.y), bflo(a.z), bfhi(a.z), bflo(a.w), bfhi(a.w), bflo(b.x), bfhi(b.x), bflo(b.y), bfhi(b.y), bflo(b.z), bfhi(b.z), bflo(b.w), bfhi(b.w)};
        float s = 0.f;
#pragma unroll
        for (int e = 0; e < 16; ++e) s += v[e] * v[e];
        s = wave_sum(s, lane);
        const float rs = 1.0f / sqrtf(s * (1.0f / DM) + EPS);
        const f32x4* gp = (const f32x4*)(gain + 16 * lane); f32x4* op = (f32x4*)(out + (size_t)row * DM + 16 * lane);
#pragma unroll
        for (int q = 0; q < 4; ++q) { const f32x4 gg = gp[q]; op[q] = (f32x4){v[4 * q] * rs * gg[0], v[4 * q + 1] * rs * gg[1], v[4 * q + 2] * rs * gg[2], v[4 * q + 3] * rs * gg[3]}; }
    }
}

__device__ __forceinline__ void transpose_item(const float* W, int K, int N, bf16_t* WT, int k0, int n0, int drow0, LAS float* scr, int lane, const float* gain) {
    const float g0 = gain ? gain[k0 + lane] : 1.0f;
    float wv[32];
#pragma unroll
    for (int i = 0; i < 32; ++i) { const int kk = 2 * i + (lane >> 5); wv[i] = W[(size_t)(k0 + kk) * N + n0 + (lane & 31)]; }
#pragma unroll
    for (int i = 0; i < 32; ++i) { const int kk = 2 * i + (lane >> 5); scr[kk * 33 + (lane & 31)] = wv[i] * shl_(g0, kk, lane); }
    asm volatile("s_waitcnt lgkmcnt(0)" ::: "memory");
    const int c = lane & 7;
#pragma unroll
    for (int j = 0; j < 4; ++j) { const int n = (lane >> 3) + 8 * j; const LAS float* s = scr + (8 * c) * 33 + n;
        u32x4 o; o.x = cvt_pk_bf16(s[0 * 33], s[1 * 33]); o.y = cvt_pk_bf16(s[2 * 33], s[3 * 33]); o.z = cvt_pk_bf16(s[4 * 33], s[5 * 33]); o.w = cvt_pk_bf16(s[6 * 33], s[7 * 33]);
        *(u32x4*)(WT + (size_t)(drow0 + n) * K + k0 + 8 * c) = o; }
    asm volatile("s_waitcnt lgkmcnt(0)" ::: "memory");
}
__device__ __forceinline__ void convert_item(const float* W, bf16_t* WT, const float* gain, int it, int lane) {
    const size_t off = (size_t)it * 512 + lane * 8; const float gsc = gain[off >> 10];
    const f32x4 a = *(const f32x4*)(W + off) * gsc, b = *(const f32x4*)(W + off + 4) * gsc;
    u32x4 o; o.x = cvt_pk_bf16(a[0], a[1]); o.y = cvt_pk_bf16(a[2], a[3]); o.z = cvt_pk_bf16(b[0], b[1]); o.w = cvt_pk_bf16(b[2], b[3]);
    *(u32x4*)(WT + off) = o;
}
__device__ __forceinline__ bool prep_plain(int& it, const float* W, int K, int N, bf16_t* WT, LAS float* scr, int lane, const float* gain) {
    const int nblk = N / 32, items = (K / 64) * nblk;
    if (it >= items) { it -= items; return false; }
    const int kb = it / nblk, nb = it % nblk; transpose_item(W, K, N, WT, 64 * kb, 32 * nb, 32 * nb, scr, lane, gain); return true;
}
__device__ __forceinline__ bool prep_gu(int& it, const float* W, bf16_t* WT, LAS float* scr, int lane, const float* gain) {
    const int nblk = NGU / 32, items = (DM / 64) * nblk;
    if (it >= items) { it -= items; return false; }
    const int kb = it / nblk, nb = it % nblk, n0 = 32 * nb, half = n0 / FF, j = n0 % FF, drow = 256 * (j / 128) + 128 * half + (j % 128);
    transpose_item(W, DM, NGU, WT, 64 * kb, n0, drow, scr, lane, gain); return true;
}

__device__ __forceinline__ void pool_phase(LAS unsigned char* L, const bf16_t* X, const float* ssqp, const float* gain, bf16_t* PG, int blk, int G, int tid) {
    LAS float* RS = (LAS float*)L;
    for (int tb = blk * 128; tb < T; tb += G * 128) {
        __syncthreads();
        if (tid < 144) { const int t = tb - 16 + tid; RS[tid] = t >= 0 ? pg8::row_rs(ssqp, t) : 0.f; }
        __syncthreads();
        const int c4 = tid & 255, half = tid >> 8, g = c4 >> 6, w = 2 << g, ts = tb + half * 64, s0 = ts & (SEQ - 1);
        const f32x4 gg = ((const f32x4*)gain)[c4];
        const u32x2* xp = (const u32x2*)(X + (size_t)ts * DM) + c4;
#define LDX(idx) ({ const u32x2 _w = xp[idx]; (f32x4){bflo(_w.x), bfhi(_w.x), bflo(_w.y), bfhi(_w.y)}; })
        LAS float* rsp = RS + 16 + half * 64;
        f32x4 win = (f32x4){0.f, 0.f, 0.f, 0.f};
        const int npre = (w - 1) < s0 ? (w - 1) : s0;
        for (int j = 1; j <= npre; ++j) win += LDX(-256 * j) * rsp[-j];
        bf16_t* outp = PG + (size_t)g * T * 256 + (size_t)ts * 256 + (c4 & 63) * 4;
#pragma unroll 4
        for (int i = 0; i < 64; ++i) {
            const f32x4 hv = LDX(256 * i) * rsp[i]; win += hv;
            const int s = s0 + i; const int cnt = (s + 1) < w ? (s + 1) : w;
            const f32x4 r = (win * (1.0f / (float)cnt) - hv) * gg;
            if (s + 1 >= w) win -= LDX(256 * (i + 1 - w)) * rsp[i + 1 - w];
            u32x2 o; o.x = cvt_pk_bf16(r[0], r[1]); o.y = cvt_pk_bf16(r[2], r[3]);
            *(u32x2*)(outp + (size_t)i * 256) = o;
        }
    }
}

__device__ __forceinline__ float logsig(float z) { return fminf(z, 0.f) - __logf(1.f + __expf(-fabsf(z))); }

__device__ __forceinline__ void gla_pass1(LAS unsigned char* L, const bf16_t* PROJ, const float* T16, const float* wg2, const float* bg, float* Bbuf, bf16_t* KVS, float* DEC, int blk, int G, int tid) {
    LAS float* T16s = (LAS float*)L; LAS float* SEG = (LAS float*)(L + 4096); LAS float* BL = (LAS float*)(L + 8192);
    LAS bf16_t* KT = (LAS bf16_t*)(L + 40960); LAS bf16_t* VTs = (LAS bf16_t*)(L + 59392);
    const int lane = tid & 63, wid = tid >> 6, fr = lane & 15, fq = lane >> 4;
    const int dk = tid & 127, seg = tid >> 7, dv = tid & 255, th = tid >> 8;
    const int h = blk & 3;
    float w2[16];
#pragma unroll
    for (int r = 0; r < 16; ++r) w2[r] = wg2[r * 512 + h * 128 + dk];
    const float bgv = bg[h * 128 + dk];
    unsigned kraw[16], vraw[16]; f32x4 t16r = (f32x4){0.f, 0.f, 0.f, 0.f};
#define P1_LOAD(unit_) do { const int n_ = ((unit_) >> 2) & 63, b_ = (unit_) >> 8, t0_ = b_ * SEQ + n_ * 64; \
        _Pragma("unroll") for (int i = 0; i < 16; ++i) kraw[i] = PROJ[(size_t)(t0_ + seg * 16 + i) * NPROJ + 512 + h * 128 + dk]; \
        _Pragma("unroll") for (int i = 0; i < 16; ++i) { const unsigned v0 = PROJ[(size_t)(t0_ + th * 32 + 2 * i) * NPROJ + 1024 + h * 256 + dv], v1 = PROJ[(size_t)(t0_ + th * 32 + 2 * i + 1) * NPROJ + 1024 + h * 256 + dv]; vraw[i] = v0 | (v1 << 16); } \
        if (tid < 256) t16r = ((const f32x4*)(T16 + (size_t)t0_ * 16))[tid]; } while (0)
    if (blk < 2048) P1_LOAD(blk);
    for (int unit = blk; unit < 2048; unit += G) {
        const int n = (unit >> 2) & 63, b = unit >> 8, t0 = b * SEQ + n * 64, cidx = (b * 4 + h) * 64 + n;
        __syncthreads();
        if (tid < 256) ((LAS f32x4*)T16s)[tid] = t16r;
        __syncthreads();
        float run = 0.f;
#pragma unroll 4
        for (int i = 0; i < 16; ++i) { const int tok = seg * 16 + i; float z = bgv;
#pragma unroll
            for (int r = 0; r < 16; ++r) z += T16s[tok * 16 + r] * w2[r];
            run += logsig(z) * (1.0f / 16.0f); BL[tok * 128 + dk] = run; }
        SEG[seg * 128 + dk] = run;
        __syncthreads();
        float offs = 0.f, total = 0.f;
#pragma unroll
        for (int s = 0; s < 4; ++s) { const float v = SEG[s * 128 + dk]; total += v; if (s < seg) offs += v; }
#pragma unroll
        for (int i = 0; i < 16; i += 2) { const int tok = seg * 16 + i;
            const float b0 = BL[tok * 128 + dk] + offs, b1 = BL[(tok + 1) * 128 + dk] + offs;
            Bbuf[(size_t)(t0 + tok) * 512 + h * 128 + dk] = b0; Bbuf[(size_t)(t0 + tok + 1) * 512 + h * 128 + dk] = b1;
            const float k0 = bf2f(kraw[i]), k1 = bf2f(kraw[i + 1]);
            *(LAS unsigned*)(KT + dk * 72 + tok) = cvt_pk_bf16(k0 * __expf(total - b0), k1 * __expf(total - b1)); }
        if (seg == 0) DEC[(size_t)cidx * 128 + dk] = __expf(total);
#pragma unroll
        for (int i = 0; i < 16; ++i) *(LAS unsigned*)(VTs + dv * 72 + th * 32 + 2 * i) = vraw[i];
        if (unit + G < 2048) P1_LOAD(unit + G);
        __syncthreads();
        bf16x8 X[2];
#pragma unroll
        for (int s = 0; s < 2; ++s) X[s] = *(const LAS bf16x8*)(KT + (16 * wid + fr) * 72 + 32 * s + 8 * fq);
#pragma unroll 4
        for (int nt = 0; nt < 16; ++nt) { f32x4 acc = (f32x4){0.f, 0.f, 0.f, 0.f};
#pragma unroll
            for (int s = 0; s < 2; ++s) { const bf16x8 Y = *(const LAS bf16x8*)(VTs + (16 * nt + fr) * 72 + 32 * s + 8 * fq); acc = __builtin_amdgcn_mfma_f32_16x16x32_bf16(X[s], Y, acc, 0, 0, 0); }
            u32x2 o; o.x = cvt_pk_bf16(acc[0], acc[1]); o.y = cvt_pk_bf16(acc[2], acc[3]);
            *(u32x2*)(KVS + ((size_t)cidx * 256 + 16 * nt + fr) * 128 + 16 * wid + 4 * fq) = o; }
    }
#undef P1_LOAD
}

__device__ __forceinline__ void gla_scan(bf16_t* KVS, const float* DEC, int gtid, int nthreads) {
    for (int item = gtid; item < 32 * 256 * 32; item += nthreads) {
        const int dk4 = item & 31, dv = (item >> 5) & 255, bh = item >> 13;
        bf16_t* p = KVS + ((size_t)bh * 64 * 256 + dv) * 128 + dk4 * 4;
        const float* d = DEC + (size_t)bh * 64 * 128 + dk4 * 4;
        f32x4 S = (f32x4){0.f, 0.f, 0.f, 0.f};
        for (int n0 = 0; n0 < 64; n0 += 16) {
            u32x2 kv[16]; f32x4 dc[16];
#pragma unroll
            for (int k = 0; k < 16; ++k) { kv[k] = *(const u32x2*)(p + (size_t)(n0 + k) * 32768); dc[k] = *(const f32x4*)(d + (n0 + k) * 128); }
#pragma unroll
            for (int k = 0; k < 16; ++k) { u32x2 o; o.x = cvt_pk_bf16(S[0], S[1]); o.y = cvt_pk_bf16(S[2], S[3]); *(u32x2*)(p + (size_t)(n0 + k) * 32768) = o;
                S[0] = dc[k][0] * S[0] + bflo(kv[k].x); S[1] = dc[k][1] * S[1] + bfhi(kv[k].x); S[2] = dc[k][2] * S[2] + bflo(kv[k].y); S[3] = dc[k][3] * S[3] + bfhi(kv[k].y); }
        }
    }
}

__device__ __forceinline__ void gla_pass3(LAS unsigned char* L, bf16_t* PROJ, const float* Bbuf, const bf16_t* KVS, const float* onorm, int blk, int G, int tid) {
    LAS bf16_t* QIN = (LAS bf16_t*)L; LAS bf16_t* QA = (LAS bf16_t*)(L + 17408); LAS bf16_t* KA = (LAS bf16_t*)(L + 34816);
    LAS bf16_t* VTs = (LAS bf16_t*)(L + 52224); LAS float* SSQ = (LAS float*)(L + 107520);
    const int lane = tid & 63, wid = tid >> 6, fr = lane & 15, fq = lane >> 4, rg = wid & 3, ch = wid >> 2;
    LAS bf16_t* AM = (LAS bf16_t*)(L + 89088 + wid * 2304);
    const int h = blk & 3;
    const int dv = tid & 255, th = tid >> 8, tok = tid >> 3, dkc = (tid & 7) * 16;
    unsigned vraw[16]; f32x4 bA[2], bB[2], rA[2], rB[2]; u32x4 q8[2], k8[2];
#define P3_LOAD(unit_) do { const int n_ = ((unit_) >> 2) & 63, b_ = (unit_) >> 8, t0_ = b_ * SEQ + n_ * 64; \
        _Pragma("unroll") for (int i = 0; i < 16; ++i) { const unsigned v0 = PROJ[(size_t)(t0_ + th * 32 + 2 * i) * NPROJ + 1024 + h * 256 + dv], v1 = PROJ[(size_t)(t0_ + th * 32 + 2 * i + 1) * NPROJ + 1024 + h * 256 + dv]; vraw[i] = v0 | (v1 << 16); } \
        const float* bp_ = Bbuf + (size_t)(t0_ + tok) * 512 + h * 128 + dkc; const float* brp_ = Bbuf + (size_t)(t0_ + 31) * 512 + h * 128 + dkc; const bf16_t* qp_ = PROJ + (size_t)(t0_ + tok) * NPROJ + h * 128 + dkc; \
        _Pragma("unroll") for (int c = 0; c < 2; ++c) { bA[c] = *(const f32x4*)(bp_ + 8 * c); bB[c] = *(const f32x4*)(bp_ + 8 * c + 4); rA[c] = *(const f32x4*)(brp_ + 8 * c); rB[c] = *(const f32x4*)(brp_ + 8 * c + 4); \
            q8[c] = *(const u32x4*)(qp_ + 8 * c); k8[c] = *(const u32x4*)(qp_ + 512 + 8 * c); } } while (0)
    if (blk < 2048) P3_LOAD(blk);
    for (int unit = blk; unit < 2048; unit += G) {
        const int n = (unit >> 2) & 63, b = unit >> 8, t0 = b * SEQ + n * 64, cidx = (b * 4 + h) * 64 + n;
        __syncthreads();
#pragma unroll
        for (int c = 0; c < 2; ++c) {
            float bv[8] = {bA[c][0], bA[c][1], bA[c][2], bA[c][3], bB[c][0], bB[c][1], bB[c][2], bB[c][3]}, rv[8] = {rA[c][0], rA[c][1], rA[c][2], rA[c][3], rB[c][0], rB[c][1], rB[c][2], rB[c][3]};
            float qv[8] = {bflo(q8[c].x), bfhi(q8[c].x), bflo(q8[c].y), bfhi(q8[c].y), bflo(q8[c].z), bfhi(q8[c].z), bflo(q8[c].w), bfhi(q8[c].w)};
            float kv[8] = {bflo(k8[c].x), bfhi(k8[c].x), bflo(k8[c].y), bfhi(k8[c].y), bflo(k8[c].z), bfhi(k8[c].z), bflo(k8[c].w), bfhi(k8[c].w)};
            float qi[8], qa[8], ka[8];
#pragma unroll
            for (int e = 0; e < 8; ++e) { const float qs = qv[e] * 0.08838834764831845f; qi[e] = qs * __expf(bv[e]); qa[e] = qs * __expf(bv[e] - rv[e]); ka[e] = kv[e] * __expf(rv[e] - bv[e]); }
            u32x4 w;
            w.x = cvt_pk_bf16(qi[0], qi[1]); w.y = cvt_pk_bf16(qi[2], qi[3]); w.z = cvt_pk_bf16(qi[4], qi[5]); w.w = cvt_pk_bf16(qi[6], qi[7]); *(LAS u32x4*)(QIN + tok * 136 + dkc + 8 * c) = w;
            w.x = cvt_pk_bf16(qa[0], qa[1]); w.y = cvt_pk_bf16(qa[2], qa[3]); w.z = cvt_pk_bf16(qa[4], qa[5]); w.w = cvt_pk_bf16(qa[6], qa[7]); *(LAS u32x4*)(QA + tok * 136 + dkc + 8 * c) = w;
            w.x = cvt_pk_bf16(ka[0], ka[1]); w.y = cvt_pk_bf16(ka[2], ka[3]); w.z = cvt_pk_bf16(ka[4], ka[5]); w.w = cvt_pk_bf16(ka[6], ka[7]); *(LAS u32x4*)(KA + tok * 136 + dkc + 8 * c) = w;
        }
#pragma unroll
        for (int i = 0; i < 16; ++i) *(LAS unsigned*)(VTs + dv * 72 + th * 32 + 2 * i) = vraw[i];
        bf16x8 XS[4][4];
#pragma unroll
        for (int nt = 0; nt < 4; ++nt)
#pragma unroll
            for (int s = 0; s < 4; ++s) XS[nt][s] = *(const bf16x8*)(KVS + ((size_t)cidx * 256 + 16 * (8 * ch + nt) + fr) * 128 + 32 * s + 8 * fq);
        __syncthreads();
        bf16_t* rowp = PROJ + (size_t)(t0 + 16 * rg + fr) * NPROJ + h * 256;
        u32x2 r4v[8];
#pragma unroll
        for (int nt = 0; nt < 8; ++nt) r4v[nt] = *(const u32x2*)(rowp + 2048 + 16 * (8 * ch + nt) + 4 * fq);
        {
            bf16x8 Yq[4];
#pragma unroll
            for (int s = 0; s < 4; ++s) Yq[s] = *(const LAS bf16x8*)(QA + (16 * rg + fr) * 136 + 32 * s + 8 * fq);
#pragma unroll
            for (int jt = 0; jt < 4; ++jt) { f32x4 a = (f32x4){0.f, 0.f, 0.f, 0.f};
                if (jt <= rg) {
#pragma unroll
                    for (int s = 0; s < 4; ++s) { const bf16x8 X = *(const LAS bf16x8*)(KA + (16 * jt + fr) * 136 + 32 * s + 8 * fq); a = __builtin_amdgcn_mfma_f32_16x16x32_bf16(X, Yq[s], a, 0, 0, 0); }
                }
#pragma unroll
                for (int e = 0; e < 4; ++e) if (16 * jt + 4 * fq + e > 16 * rg + fr) a[e] = 0.f;
                u32x2 o; o.x = cvt_pk_bf16(a[0], a[1]); o.y = cvt_pk_bf16(a[2], a[3]);
                *(LAS u32x2*)(AM + fr * 72 + 16 * jt + 4 * fq) = o; }
        }
        asm volatile("s_waitcnt lgkmcnt(0)" ::: "memory");
        if (unit + G < 2048) P3_LOAD(unit + G);
        bf16x8 YA[2], YQ[4];
#pragma unroll
        for (int s = 0; s < 2; ++s) YA[s] = *(const LAS bf16x8*)(AM + fr * 72 + 32 * s + 8 * fq);
#pragma unroll
        for (int s = 0; s < 4; ++s) YQ[s] = *(const LAS bf16x8*)(QIN + (16 * rg + fr) * 136 + 32 * s + 8 * fq);
        f32x4 o[8]; float ssq = 0.f;
#pragma unroll
        for (int hf = 0; hf < 2; ++hf) {
#pragma unroll
            for (int q = 0; q < 4; ++q) { const int nt = 4 * hf + q, dvt = 8 * ch + nt; f32x4 acc = (f32x4){0.f, 0.f, 0.f, 0.f};
#pragma unroll
                for (int s = 0; s < 2; ++s) { const bf16x8 X = *(const LAS bf16x8*)(VTs + (16 * dvt + fr) * 72 + 32 * s + 8 * fq); acc = __builtin_amdgcn_mfma_f32_16x16x32_bf16(X, YA[s], acc, 0, 0, 0); }
#pragma unroll
                for (int s = 0; s < 4; ++s) acc = __builtin_amdgcn_mfma_f32_16x16x32_bf16(XS[q][s], YQ[s], acc, 0, 0, 0);
                o[nt] = acc; ssq += (acc[0] * acc[0] + acc[1] * acc[1]) + (acc[2] * acc[2] + acc[3] * acc[3]); }
            if (hf == 0) {
#pragma unroll
                for (int nt = 0; nt < 4; ++nt)
#pragma unroll
                    for (int s = 0; s < 4; ++s) XS[nt][s] = *(const bf16x8*)(KVS + ((size_t)cidx * 256 + 16 * (8 * ch + 4 + nt) + fr) * 128 + 32 * s + 8 * fq);
            }
        }
        ssq += shx(ssq, 16, lane); ssq += shx(ssq, 32, lane);
        if (fq == 0) SSQ[(16 * rg + fr) * 2 + ch] = ssq;
        __syncthreads();
        const float tot = SSQ[(16 * rg + fr) * 2] + SSQ[(16 * rg + fr) * 2 + 1];
        const float rs = 1.0f / sqrtf(tot * (1.0f / 256.0f) + EPS);
#pragma unroll
        for (int nt = 0; nt < 8; ++nt) { const int dv0 = 16 * (8 * ch + nt) + 4 * fq;
            const f32x4 g4 = *(const f32x4*)(onorm + dv0); const u32x2 r4 = r4v[nt];
            const float v0 = o[nt][0] * rs * g4[0] * silu_f(bflo(r4.x)), v1 = o[nt][1] * rs * g4[1] * silu_f(bfhi(r4.x)), v2 = o[nt][2] * rs * g4[2] * silu_f(bflo(r4.y)), v3 = o[nt][3] * rs * g4[3] * silu_f(bfhi(r4.y));
            u32x2 w; w.x = cvt_pk_bf16(v0, v1); w.y = cvt_pk_bf16(v2, v3);
            *(u32x2*)(rowp + 1024 + dv0) = w; }
    }
#undef P3_LOAD
}

#define XB_TMO      128
#define XB_XCNT(j)  (256  + 64 * (j))
#define XB_XSUB(j)  (1280 + 64 * (j))
#define XB_XGEN(j)  (2304 + 64 * (j))
#define XB_TOP      3328
#define XB_TOPGEN   3392
#define XCD_BAR_WORDS 3456
#define XB_SPIN_CAP (1u << 24)

__device__ __forceinline__ unsigned xb_ld(unsigned* p)              { return __hip_atomic_load(p, __ATOMIC_RELAXED, __HIP_MEMORY_SCOPE_AGENT); }
__device__ __forceinline__ unsigned xb_add(unsigned* p, unsigned v) { return __hip_atomic_fetch_add(p, v, __ATOMIC_RELAXED, __HIP_MEMORY_SCOPE_AGENT); }
__device__ __forceinline__ unsigned xb_xcc_id() { return (unsigned)__builtin_amdgcn_s_getreg((3 << 11) | 20) & 0xFu; }
#define XB_SPIN(cond, bar) do { unsigned _sp = 0; while (cond) { __builtin_amdgcn_s_sleep(1); \
    if ((++_sp & 255u) == 0u) { if (xb_ld(&(bar)[XB_TMO])) break; if (_sp > XB_SPIN_CAP) { atomicAdd(&(bar)[XB_TMO], 1u); break; } } } } while (0)

struct XcdBarrier {
    unsigned* bar; unsigned x;
    volatile LAS unsigned* st;
};

__device__ __forceinline__ XcdBarrier xcd_barrier_post(unsigned* bar, volatile LAS unsigned* st) {
    XcdBarrier b; b.bar = bar; b.x = xb_xcc_id(); b.st = st;
    if (threadIdx.x == 0) (void)xb_add(&bar[XB_XCNT(b.x)], 1u);
    return b;
}
__device__ __forceinline__ void xcd_barrier_complete(unsigned* bar, unsigned x, unsigned& nloc, unsigned& nx) {
    const unsigned G = gridDim.x * gridDim.y * gridDim.z;
    unsigned sum, cnt, mine, sp = 0u;
    for (;;) {
        sum = 0u; cnt = 0u; mine = 0u;
#pragma unroll
        for (unsigned j = 0; j < 16; ++j) { const unsigned c = xb_ld(&bar[XB_XCNT(j)]); sum += c; cnt += (c > 0u) ? 1u : 0u; mine = (j == x) ? c : mine; }
        if (sum == G) break;
        __builtin_amdgcn_s_sleep(1);
        if ((++sp & 255u) == 0u) { if (xb_ld(&bar[XB_TMO])) break; if (sp > XB_SPIN_CAP) { atomicAdd(&bar[XB_TMO], 1u); break; } }
    }
    nloc = mine > 0u ? mine : 1u; nx = cnt > 0u ? cnt : 1u;
}

__device__ __forceinline__ void xcd_barrier(const XcdBarrier& b) {
    asm volatile("s_waitcnt vmcnt(0)" ::: "memory");
    __syncthreads();
    if (threadIdx.x == 0) {
        unsigned* bar = b.bar;
        __builtin_amdgcn_s_waitcnt(0);
        unsigned nloc = b.st[0], nx = b.st[1];
        if (nloc == 0u) { xcd_barrier_complete(bar, b.x, nloc, nx); b.st[0] = nloc; b.st[1] = nx; }
        const unsigned old = xb_add(&bar[XB_XSUB(b.x)], 1u);
        const unsigned gen = old / nloc;
        if (old + 1u == (gen + 1u) * nloc) {
            __builtin_amdgcn_fence(__ATOMIC_RELEASE, "agent");
            asm volatile("s_waitcnt vmcnt(0)" ::: "memory");
            const unsigned og = xb_add(&bar[XB_TOP], 1u);
            const unsigned tg = og / nx;
            if (og + 1u == (tg + 1u) * nx) xb_add(&bar[XB_TOPGEN], 1u);
            else XB_SPIN(xb_ld(&bar[XB_TOPGEN]) == tg, bar);
            __builtin_amdgcn_fence(__ATOMIC_ACQUIRE, "agent");
            asm volatile("s_waitcnt vmcnt(0)" ::: "memory");
        } else {
            XB_SPIN(xb_ld(&bar[XB_TOPGEN]) == gen, bar);
            __builtin_amdgcn_fence(__ATOMIC_ACQUIRE, "agent");
            asm volatile("s_waitcnt vmcnt(0)" ::: "memory");
        }
    }
    __syncthreads();
}

struct Params { const float* in[24]; float* out; unsigned char* ws; };
enum { K_NONE = 0, K_BF16, K_SWIGLU, K_RESID, K_SOFTMAX, K_PREP, K_NORM, K_POOL, K_GLA1, K_SCAN, K_GLA3, K_KMVT, K_XPRE };

__global__ void __launch_bounds__(512) fwd_megakernel(Params p) {
    extern __shared__ __attribute__((aligned(16))) unsigned char lds_raw[];
    cg::grid_group grid = cg::this_grid();
    LAS unsigned char* L = (LAS unsigned char*)lds_raw;
    const int G = gridDim.x, blk = blockIdx.x;
    const int ngw = G * 8, nthreads = G * 512;
    unsigned char* const ws0 = p.ws;
#define WSB(off) ((bf16_t*)(ws + (off)))
#define WSF(off) ((float*)(ws + (off)))
    if (threadIdx.x < 2) ((volatile LAS unsigned*)(L + BARST_OFF))[threadIdx.x] = 0u;
    __syncthreads();
    const XcdBarrier bar = xcd_barrier_post((unsigned*)ws0, (volatile LAS unsigned*)(L + BARST_OFF));
    grid.sync();

#ifdef REP_K
#ifdef REP_K2
    constexpr int NK = 21;
#else
    constexpr int NK = 20;
#endif
#else
    constexpr int NK = 19;
#endif
#pragma unroll 1
    for (int op = 0; op < 4 * NK + 1; ++op) {
        const __attribute__((address_space(4))) unsigned long long* KA = (const __attribute__((address_space(4))) unsigned long long*)__builtin_amdgcn_kernarg_segment_ptr(); asm volatile("" : "+s"(KA));
#define PIN(i) ((const float*)KA[i])
        unsigned char* ws = (unsigned char*)KA[25]; float* const X = (float*)KA[24];
        bf16_t* const MQ = (bf16_t*)((unsigned char*)X + 64 * MiB); bf16_t* const NVT = (bf16_t*)((unsigned char*)X + 80 * MiB);
        int tid = threadIdx.x; asm volatile("" : "+v"(tid));
        const int lane = tid & 63, wave = __builtin_amdgcn_readfirstlane(tid >> 6), gw = blk * 8 + wave, gtid = blk * 512 + tid;
#ifdef DBG_STOP
        if (op > DBG_STOP && op < 4 * NK) continue;
#endif
        const int layer = op / NK; int k = op - layer * NK;
        const bool extra = (k >= 19);
#ifdef REP_K2
        if (k == 20) k = REP_K2; else
#endif
#ifdef REP_K
        if (k == 19) k = REP_K;
#endif
        const int jm = layer >> 1; const bool is_gla = (layer & 1) == 0;
        int kind = K_NONE; bool sync = true; int order_c = blk;
        pg8::Gemm g = pg8::mk_gemm(nullptr, DM, nullptr, DM, T, DM, DM);
        bf16_t* eO = nullptr; int eldc = DM; float escale = 1.0f; const float* essq = nullptr; float* et16 = nullptr;
        bf16_t* rout = extra ? WSB(WS_KVS) : WSB(WS_XN); float ralpha = 1.0f; const float* rbias = nullptr; const float* rscale = nullptr;
        const float* nsrc = X; const float* ngain = nullptr; int nmode = 0; float* nfout = nullptr;
#ifdef DBG_DIGEST
        if (layer == 4) {
            const float* t16 = WSF(WS_T16); const bf16_t* proj = WSB(WS_PROJ); const float* bb = WSF(WS_XN); const float* dec = WSF(WS_DEC); const bf16_t* kvs = WSB(WS_KVS);
            for (size_t i = gtid; i < (size_t)T * DM; i += nthreads) {
                const size_t r = i >> 10, c = i & 1023; float code = 0.f;
#define BADF(v) (!(fabsf(v) < 1e6f))
                if ((DBG_MASK & 64) && BADF(t16[i % ((size_t)T * 16)])) code += 64.f;
                if ((DBG_MASK & 32) && (BADF(bf2f(proj[r * NPROJ + c])) || BADF(bf2f(proj[r * NPROJ + 2048 + c])))) code += 32.f;
                if ((DBG_MASK & 16) && BADF(bb[i % ((size_t)T * 512)])) code += 16.f;
                if ((DBG_MASK & 8) && BADF(dec[i % ((size_t)2048 * 128)])) code += 8.f;
                if ((DBG_MASK & 4) && (BADF(bf2f(kvs[i])) || BADF(bf2f(kvs[i + (size_t)T * DM])))) code += 4.f;
                if ((DBG_MASK & 1) && BADF(bf2f(proj[r * NPROJ + 1024 + c]))) code += 1.f;
                X[i] = code * 1000.f + bf2f(kvs[i]) + bf2f(kvs[i + (size_t)T * DM]);
            }
            break;
        }
#endif
        if (layer == 4) { kind = K_NORM; sync = false; }
        else switch (k) {
            case 0: kind = K_PREP; break;
            case 1: kind = K_SWIGLU; g = pg8::mk_gemm(WSB(WS_XN), DM, WSB(WS_WGU1), DM, T, NGU, DM); eO = WSB(WS_ACT); sync = false; break;
            case 2: if (layer == 0) kind = K_KMVT; else sync = false; break;
            case 3: kind = K_XPRE; break;
            case 4: kind = K_RESID; g = pg8::mk_gemm(WSB(WS_ACT), FF, WSB(WS_WD1), FF, T, DM, FF); ralpha = 0.5f; break;
            case 5: sync = false; break;
            case 6: if (is_gla) { kind = K_BF16; g = pg8::mk_gemm(WSB(WS_XN), DM, WSB(WS_WIN), DM, T, NPROJP, DM); eO = WSB(WS_PROJ); eldc = NPROJ; essq = WSF(WS_SSQP); et16 = WSF(WS_T16); } else kind = K_POOL; break;
            case 7: if (is_gla) kind = K_GLA1; else { kind = K_RESID; g = pg8::mk_gemm(WSB(WS_PG), 256, WSB(WS_WPOOL), 256, T, DM, 256); g.a_pn = (long)T * 256 * 2; rbias = PIN(13) + jm * DM; rscale = PIN(14) + jm * DM; } break;
            case 8: if (is_gla) kind = K_SCAN; else sync = false; break;
            case 9: if (is_gla) kind = K_GLA3; else sync = false; break;
            case 10: if (is_gla) { kind = K_RESID; g = pg8::mk_gemm(WSB(WS_PROJ) + 1024, NPROJ, WSB(WS_WOUT), DM, T, DM, DM); } else sync = false; break;
            case 11: sync = false; break;
            case 12: sync = false; break;
            case 13: kind = K_SOFTMAX; g = pg8::mk_gemm(WSB(WS_XN), DM, MQ, DM, T, DM, DM); g.b_pb = (long)DM * DM * 2; eO = WSB(WS_P); break;
            case 14: sync = false; break;
            case 15: kind = K_RESID; g = pg8::mk_gemm(WSB(WS_P), DM, NVT, DM, T, DM, DM); g.b_pb = (long)DM * DM * 2; break;
            case 16: sync = false; break;
            case 17: kind = K_SWIGLU; g = pg8::mk_gemm(WSB(WS_XN), DM, WSB(WS_WGU2), DM, T, NGU, DM); eO = WSB(WS_ACT); break;
            default: kind = K_RESID; g = pg8::mk_gemm(WSB(WS_ACT), FF, WSB(WS_WD2), FF, T, DM, FF); ralpha = 0.5f; break;
        }
        if (extra) sync = true;
        switch (kind) {
            case K_BF16: case K_KMVT: case K_XPRE: {
                const int nj = kind == K_KMVT ? 8 : (kind == K_XPRE ? 2 : 1);
#pragma unroll 1
                for (int j = 0; j < nj; ++j) {
                    if (kind == K_KMVT) { const int l = j >> 1; const bf16_t* wkv = WSB(WS_WKV4) + (size_t)l * 2048 * DM; order_c = (blk + 32 * j) % G;
                        g = pg8::mk_gemm(WSB(WS_MEMN), DM, wkv + (size_t)(j & 1) * DM * DM, DM, 2048, DM, DM); eO = ((j & 1) ? WSB(WS_VT4) : WSB(WS_KM4)) + (size_t)l * 2048 * DM; eldc = DM; }
                    if (kind == K_XPRE) { order_c = (blk + 128 * j) % G;
                        if (j == 0) { g = pg8::mk_gemm(WSB(WS_KM4) + (size_t)layer * 2048 * DM, DM, WSB(WS_WQ), DM, 8192, DM, 256); g.mode = 1; eO = MQ; }
                        else { g = pg8::mk_gemm(WSB(WS_WO), DM, WSB(WS_VT4) + (size_t)layer * 2048 * DM, DM, 8192, DM, 256); g.mode = 2; eO = NVT; }
                        eldc = DM; }
                    pg8::StaticOrder S; S.init(g.M, g.N, G, order_c); pg8::EpiBf16 E{eO, eldc, escale, essq, et16, (LAS float*)(L + SMX_OFF + 8192 + 256)}; pg8::gemm_phase(L, g, S, E, tid);
                } } break;
            case K_SWIGLU: { pg8::StaticOrder S; S.init(g.M, g.N, G, order_c); pg8::EpiSwiglu E{eO, WSF(WS_SSQP), (LAS float*)(L + SMX_OFF + 8192 + 256)}; pg8::gemm_phase(L, g, S, E, tid); } break;
            case K_RESID: { pg8::StaticOrder S; S.init(g.M, g.N, G, order_c); pg8::EpiResid E{WSB(WS_XN), rout, ralpha, rbias, rscale, extra ? nullptr : WSF(WS_SSQP)}; pg8::gemm_phase(L, g, S, E, tid); } break;
            case K_SOFTMAX: { pg8::StaticOrder S; S.init(g.M, g.N, G, order_c); pg8::EpiSoftmax E{eO, L + SMX_OFF, WSF(WS_SSQP), 0.0625f}; pg8::gemm_phase(L, g, S, E, tid); } break;
            case K_PREP: {
                LAS float* scr = (LAS float*)(L + wave * 16384);
                const int nkv = layer == 0 ? 4 * (16 * 64) : 0;
                const int total = 2 * (16 * 176) + 2 * (44 * 32) + 2048 + nkv + 16 * 32 + (is_gla ? (16 * 96 + 16 * 32 + 16 + 480) : 4 * (4 * 8));
#pragma unroll 1
                for (int it0 = gw; it0 < total; it0 += ngw) {
                    int it = it0;
                    if (prep_gu(it, PIN(3) + (size_t)layer * DM * NGU, WSB(WS_WGU1), scr, lane, PIN(2) + layer * DM)) continue;
                    if (prep_gu(it, PIN(21) + (size_t)layer * DM * NGU, WSB(WS_WGU2), scr, lane, PIN(20) + layer * DM)) continue;
                    const float* W; bf16_t* WT; int Kd, Nd; const float* gn = nullptr;
                    if (it < 44 * 32) { W = PIN(4) + (size_t)layer * FF * DM; WT = WSB(WS_WD1); Kd = FF; Nd = DM; }
                    else if ((it -= 44 * 32) < 44 * 32) { W = PIN(22) + (size_t)layer * FF * DM; WT = WSB(WS_WD2); Kd = FF; Nd = DM; }
                    else if ((it -= 44 * 32) < 2048) { convert_item(PIN(17) + (size_t)layer * DM * DM, WSB(WS_WQ), PIN(15) + layer * DM, it, lane); continue; }
                    else if ((it -= 2048) < nkv) { const int l = it >> 10; it &= 1023; W = PIN(18) + (size_t)l * DM * 2048; WT = WSB(WS_WKV4) + (size_t)l * 2048 * DM; Kd = DM; Nd = 2048; gn = PIN(16) + l * DM; }
                    else if ((it -= nkv) < 16 * 32) { W = PIN(19) + (size_t)layer * DM * DM; WT = WSB(WS_WO); Kd = DM; Nd = DM; }
                    else { it -= 16 * 32;
                        if (is_gla) {
                            if (it < 16 * 96) { W = PIN(6) + (size_t)jm * DM * NPROJ; WT = WSB(WS_WIN); Kd = DM; Nd = NPROJ; gn = PIN(5) + layer * DM; }
                            else if ((it -= 16 * 96) < 16 * 32) { W = PIN(11) + (size_t)jm * DM * DM; WT = WSB(WS_WOUT); Kd = DM; Nd = DM; }
                            else if ((it -= 16 * 32) < 16) {
                                const int r = lane & 15, kq = lane >> 4, kb = it * 64 + kq * 16; const float* wg1 = PIN(7) + (size_t)jm * DM * 16; const float* gm = PIN(5) + layer * DM;
                                bf16_t* d = WSB(WS_WIN) + (size_t)(NPROJ + r) * DM + kb;
#pragma unroll
                                for (int i = 0; i < 16; i += 2) *(unsigned*)(d + i) = cvt_pk_bf16(gm[kb + i] * wg1[(size_t)(kb + i) * 16 + r], gm[kb + i + 1] * wg1[(size_t)(kb + i + 1) * 16 + r]);
                                continue; }
                            else { it -= 16;
                                unsigned zz = 0u; asm volatile("" : "+v"(zz));
                                *(u32x4*)((unsigned char*)(WSB(WS_WIN) + (size_t)(NPROJ + 16) * DM) + (size_t)it * 1024 + lane * 16) = (u32x4){zz, zz, zz, zz}; continue; }
                        }
                        else { const int gq = it >> 5; it &= 31; W = PIN(12) + (size_t)(jm * 4 + gq) * 65536; WT = WSB(WS_WPOOL) + gq * 65536; Kd = 256; Nd = 256; } }
                    prep_plain(it, W, Kd, Nd, WT, scr, lane, gn);
                }
                if (layer == 0) norm_phase(PIN(1), nullptr, WSB(WS_MEMN), nullptr, nullptr, nullptr, 0, 2048, gw, ngw, lane);
                if (layer == 0) norm_phase(PIN(0), nullptr, WSB(WS_XN), nullptr, nullptr, WSF(WS_SSQP), 3, T, gw, ngw, lane);
            } break;
            case K_NORM: final_norm(WSB(WS_XN), PIN(23), X, gw, ngw, lane); break;
            case K_POOL: pool_phase(L, WSB(WS_XN), WSF(WS_SSQP), PIN(5) + layer * DM, WSB(WS_PG), blk, G, tid); break;
            case K_GLA1: gla_pass1(L, WSB(WS_PROJ), WSF(WS_T16), PIN(8) + (size_t)jm * 16 * 512, PIN(9) + jm * 512, extra ? WSF(WS_P) : X, WSB(WS_KVS), WSF(WS_DEC), blk, G, tid); break;
            case K_SCAN: gla_scan(WSB(WS_KVS), WSF(WS_DEC), gtid, nthreads); break;
            case K_GLA3: gla_pass3(L, WSB(WS_PROJ), X, WSB(WS_KVS), PIN(10) + jm * 256, blk, G, tid); break;
            default: break;
        }
        if (sync) xcd_barrier(bar);
    }
}

extern "C" void kernel_launch(void* const* d_in, const int* in_sizes, int n_in, void* d_out, int out_size, void* d_ws, size_t ws_size, hipStream_t stream) {
    static int grid_blocks = 0;
    if (grid_blocks == 0) {
        if (n_in != 24 || out_size != T * DM || ws_size < WS_END) { fprintf(stderr, "kernel_launch: unexpected sizes (n_in %d out %d ws %zu)\n", n_in, out_size, ws_size); grid_blocks = -1; return; }
        int dev = 0, cus = 0, per_cu = 0;
        hipGetDevice(&dev);
        hipDeviceGetAttribute(&cus, hipDeviceAttributeMultiprocessorCount, dev);
        hipFuncSetAttribute((const void*)fwd_megakernel, hipFuncAttributeMaxDynamicSharedMemorySize, LDS_BYTES);
        hipOccupancyMaxActiveBlocksPerMultiprocessor(&per_cu, (const void*)fwd_megakernel, 512, LDS_BYTES);
        if (per_cu < 1) { fprintf(stderr, "kernel_launch: occupancy query says %d blocks per CU\n", per_cu); per_cu = 1; }
        (void)hipGetLastError();
        grid_blocks = cus & ~3;
    }
    if (grid_blocks < 0) return;
    if (hipMemsetAsync(d_ws, 0, 65536, stream) != hipSuccess) { fprintf(stderr, "kernel_launch: memset failed\n"); return; }
    Params p{};
    for (int i = 0; i < 24; ++i) p.in[i] = (const float*)d_in[i];
    p.out = (float*)d_out; p.ws = (unsigned char*)d_ws;
    void* args[] = {&p};
    hipError_t e = hipLaunchCooperativeKernel((const void*)fwd_megakernel, dim3(grid_blocks), dim3(512), args, LDS_BYTES, stream);
    if (e != hipSuccess) fprintf(stderr, "cooperative launch failed: %s (grid %d)\n", hipGetErrorString(e), grid_blocks);
}
```
